# Optimizing an MI355X kernel written in HIP

```python
import jax, jax.numpy as jnp
from jax import lax
import numpy as np

D_MODEL = 2048
BATCH = 1
SEQ = 8192
DEPTH = 4

GRID_W = 64
CTX_LEN = 256
N_FG = 4
FG_W = 256
F_WIDTH = N_FG * FG_W
N_HEADS = 16
N_KV_HEADS = 2
HEAD_DIM = 64
Q_GROUP = N_HEADS // N_KV_HEADS
ATT_WIDTH = N_HEADS * HEAD_DIM
KV_WIDTH = N_KV_HEADS * HEAD_DIM
WINDOW = 128
BLOCK = 128
ROPE_BASE = 10000.0
FA_IN = F_WIDTH + ATT_WIDTH + 2 * KV_WIDTH
FA_OUT = F_WIDTH + ATT_WIDTH
D_RNN = D_MODEL
N_RNN_BLOCKS = 8
RNN_BLOCK = D_RNN // N_RNN_BLOCKS
CONV_W = 4
CONV_LEFT = 2
LRU_C = 8.0
D_FF = 5632
FFN_CONV_W = 3
FFN_CONV_LEFT = 1
N_MOD = 6
EPS = 1e-6
NEG_INF = -1e30
N_FA = (DEPTH + 1) // 2
N_RG = DEPTH // 2

kernel_name = 'hybrid_fourier_swa_rglru_convffn_dit'


def rmsnorm(x, g):
    xf = x.astype(jnp.float32)
    r = lax.rsqrt(jnp.mean(xf * xf, axis=-1, keepdims=True) + EPS)
    return (xf * r).astype(x.dtype) * g


def modulate(h, shift, scale):
    return h * (1 + scale) + shift


def dwconv(x, w, b, left):
    k_w = w.shape[0]
    n = x.shape[1]
    xp = jnp.pad(x, ((0, 0), (left, k_w - 1 - left), (0, 0)))
    y = xp[:, 0:n] * w[0] + b
    for k in range(1, k_w):
        y = y + xp[:, k:k + n] * w[k]
    return y


def _rope_axis(t, pos):
    f = t.shape[-1] // 2
    inv = ROPE_BASE ** (-jnp.arange(f, dtype=jnp.float32) / f)
    ang = pos.astype(jnp.float32)[:, None] * inv[None, :]
    cos = jnp.cos(ang)[:, None, :].astype(t.dtype)
    sin = jnp.sin(ang)[:, None, :].astype(t.dtype)
    t1, t2 = t[..., :f], t[..., f:]
    return jnp.concatenate([t1 * cos - t2 * sin, t1 * sin + t2 * cos], axis=-1)


def rope_2d(t, row_ids, col_ids):
    half = t.shape[-1] // 2
    return jnp.concatenate([_rope_axis(t[..., :half], row_ids), _rope_axis(t[..., half:], col_ids)], axis=-1)


def fourier_mix(u):
    b, n, _ = u.shape
    ug = u.reshape(b, n, N_FG, FG_W).astype(jnp.float32)
    y = jnp.fft.fft2(ug, axes=(1, 3), norm='ortho').real
    return y.reshape(b, n, F_WIDTH).astype(u.dtype)


def _split_fa(u):
    b, n = u.shape[:2]
    f = u[..., :F_WIDTH]
    q = u[..., F_WIDTH:F_WIDTH + ATT_WIDTH].reshape(b, n, N_HEADS, HEAD_DIM)
    k = u[..., F_WIDTH + ATT_WIDTH:F_WIDTH + ATT_WIDTH + KV_WIDTH].reshape(b, n, N_KV_HEADS, HEAD_DIM)
    v = u[..., F_WIDTH + ATT_WIDTH + KV_WIDTH:].reshape(b, n, N_KV_HEADS, HEAD_DIM)
    return f, q, k, v


def _window_mask(nb):
    q_pos = jnp.arange(nb)[:, None, None] * BLOCK + jnp.arange(BLOCK)[None, :, None]
    k_pos = (jnp.arange(nb)[:, None, None] - 1) * BLOCK + jnp.arange(3 * BLOCK)[None, None, :]
    return (jnp.abs(k_pos - q_pos) <= WINDOW) & (k_pos >= 0) & (k_pos < nb * BLOCK)


def _latent_attention(q, k, v, kc, vc, sink):
    b, s = q.shape[:2]
    nb = s // BLOCK
    n_ctx = kc.shape[1]
    qb = (q * HEAD_DIM ** -0.5).reshape(b, nb, BLOCK, N_KV_HEADS, Q_GROUP, HEAD_DIM)

    def bands(t):
        tp = jnp.pad(t, ((0, 0), (BLOCK, BLOCK), (0, 0), (0, 0))).reshape(b, nb + 2, BLOCK, N_KV_HEADS, HEAD_DIM)
        return jnp.concatenate([tp[:, :-2], tp[:, 1:-1], tp[:, 2:]], axis=2)

    kw, vw = bands(k), bands(v)
    s_win = jnp.einsum('bnqkgd,bnskd->bnkgqs', qb, kw).astype(jnp.float32)
    s_win = jnp.where(_window_mask(nb)[None, :, None, None], s_win, NEG_INF)
    s_ctx = jnp.einsum('bnqkgd,bckd->bnkgqc', qb, kc).astype(jnp.float32)
    sink_col = jnp.broadcast_to(sink.astype(jnp.float32).reshape(1, 1, N_KV_HEADS, Q_GROUP, 1, 1), s_win.shape[:-1] + (1,))
    p = jax.nn.softmax(jnp.concatenate([s_win, s_ctx, sink_col], axis=-1), axis=-1)
    p_win = p[..., :3 * BLOCK].astype(v.dtype)
    p_ctx = p[..., 3 * BLOCK:3 * BLOCK + n_ctx].astype(v.dtype)
    o = jnp.einsum('bnkgqs,bnskd->bnqkgd', p_win, vw) + jnp.einsum('bnkgqc,bckd->bnqkgd', p_ctx, vc)
    return o.reshape(b, s, ATT_WIDTH)


def _context_attention(qc, kc, vc, sink):
    b, n_ctx = qc.shape[:2]
    qs = (qc * HEAD_DIM ** -0.5).reshape(b, n_ctx, N_KV_HEADS, Q_GROUP, HEAD_DIM)
    s = jnp.einsum('bqkgd,bckd->bkgqc', qs, kc).astype(jnp.float32)
    sink_col = jnp.broadcast_to(sink.astype(jnp.float32).reshape(1, N_KV_HEADS, Q_GROUP, 1, 1), s.shape[:-1] + (1,))
    p = jax.nn.softmax(jnp.concatenate([s, sink_col], axis=-1), axis=-1)[..., :n_ctx].astype(vc.dtype)
    o = jnp.einsum('bkgqc,bckd->bqkgd', p, vc)
    return o.reshape(b, n_ctx, ATT_WIDTH)


def fourier_attn_mixer(h_lat, h_ctx, w_in, w_out, sink, row_ids, col_ids, ctx_out):
    f, q, k, v = _split_fa(h_lat @ w_in)
    fc, qc, kc, vc = _split_fa(h_ctx @ w_in)
    q = rope_2d(q, row_ids, col_ids)
    k = rope_2d(k, row_ids, col_ids)
    y_lat = jnp.concatenate([fourier_mix(f), _latent_attention(q, k, v, kc, vc, sink)], axis=-1) @ w_out
    y_ctx = None
    if ctx_out:
        y_ctx = jnp.concatenate([fourier_mix(fc), _context_attention(qc, kc, vc, sink)], axis=-1) @ w_out
    return y_lat, y_ctx


def _rglru_gates(xs, w_a, b_a, w_i, b_i, lam):
    b, n = xs.shape[:2]
    xb = xs.reshape(b, n, N_RNN_BLOCKS, RNN_BLOCK)
    r = jax.nn.sigmoid(jnp.einsum('blhi,hij->blhj', xb, w_a.astype(jnp.float32)).reshape(b, n, D_RNN) + b_a.astype(jnp.float32))
    i = jax.nn.sigmoid(jnp.einsum('blhi,hij->blhj', xb, w_i.astype(jnp.float32)).reshape(b, n, D_RNN) + b_i.astype(jnp.float32))
    log_a = -LRU_C * r * jax.nn.softplus(-lam.astype(jnp.float32))
    a = jnp.exp(log_a)
    gx = jnp.sqrt(-jnp.expm1(2.0 * log_a)) * (i * xs)
    return a, gx


def _linear_scan(a, gx, h0, reverse):
    def combine(e1, e2):
        a1, b1 = e1
        a2, b2 = e2
        return a1 * a2, a2 * b1 + b2
    a_cum, b_cum = lax.associative_scan(combine, (a, gx), reverse=reverse, axis=1)
    return b_cum + a_cum * h0[:, None, :]


def rglru_mixer(h_lat, h_ctx, w_in, conv_w, conv_b, w_a, b_a, w_i, b_i, lam, w_out, ctx_out):
    gate, xs = jnp.split(h_lat @ w_in, 2, axis=-1)
    xs_c = h_ctx @ w_in[:, D_RNN:]
    xs = dwconv(xs, conv_w, conv_b, CONV_LEFT).astype(jnp.float32)
    xs_c = dwconv(xs_c, conv_w, conv_b, CONV_LEFT).astype(jnp.float32)
    b = xs_c.shape[0]
    h_dirs, hc_dirs = [], []
    for d, reverse in enumerate((False, True)):
        a, gx = _rglru_gates(xs, w_a[d], b_a[d], w_i[d], b_i[d], lam[d])
        ac, gxc = _rglru_gates(xs_c, w_a[d], b_a[d], w_i[d], b_i[d], lam[d])
        hc = _linear_scan(ac, gxc, jnp.zeros((b, D_RNN), jnp.float32), reverse)
        h0 = hc[:, 0] if reverse else hc[:, -1]
        h_dirs.append(_linear_scan(a, gx, h0, reverse))
        hc_dirs.append(hc)
    y = (h_dirs[0] + h_dirs[1]).astype(h_lat.dtype) * jax.nn.gelu(gate)
    y_lat = y @ w_out
    y_ctx = None
    if ctx_out:
        gate_c = h_ctx @ w_in[:, :D_RNN]
        y_ctx = ((hc_dirs[0] + hc_dirs[1]).astype(h_ctx.dtype) * jax.nn.gelu(gate_c)) @ w_out
    return y_lat, y_ctx


def conv_ffn(h, w_up, conv_w, conv_b, w_down):
    u = dwconv(h @ w_up, conv_w, conv_b, FFN_CONV_LEFT)
    g, v = jnp.split(u, 2, axis=-1)
    return (jax.nn.silu(g) * v) @ w_down


def setup_inputs(seed: int = 0) -> dict:
    key = jax.random.key(seed)
    ks = jax.random.split(key, 32)
    f32 = jnp.float32

    def nrm(k, shape, scale):
        return jax.random.normal(k, shape, f32) * scale

    D = D_MODEL
    u = jax.random.uniform(ks[18], (N_RG, 2, D_RNN), f32, 0.9, 0.999)
    s = u ** (1.0 / LRU_C)
    return {
        'x': nrm(ks[0], (BATCH, SEQ, D), 1.0),
        'c': nrm(ks[1], (BATCH, D), 1.0),
        'ctx': nrm(ks[2], (BATCH, CTX_LEN, D), 1.0),
        'c_ctx': nrm(ks[3], (D,), 1.0),
        'w_mod': nrm(ks[4], (DEPTH, D, N_MOD * D), 0.5 * D ** -0.5),
        'b_mod': nrm(ks[5], (DEPTH, N_MOD * D), 0.02),
        'g_mix': 1.0 + nrm(ks[6], (DEPTH, D), 0.02),
        'g_ffn': 1.0 + nrm(ks[7], (DEPTH, D), 0.02),
        'fa_w_in': nrm(ks[8], (N_FA, D, FA_IN), D ** -0.5),
        'fa_w_out': nrm(ks[9], (N_FA, FA_OUT, D), FA_OUT ** -0.5),
        'attn_sink': nrm(ks[10], (N_FA, N_HEADS), 0.5),
        'rg_w_in': nrm(ks[11], (N_RG, D, 2 * D_RNN), D ** -0.5),
        'rg_conv_w': nrm(ks[12], (N_RG, CONV_W, D_RNN), CONV_W ** -0.5),
        'rg_conv_b': nrm(ks[13], (N_RG, D_RNN), 0.02),
        'rg_w_a': nrm(ks[14], (N_RG, 2, N_RNN_BLOCKS, RNN_BLOCK, RNN_BLOCK), RNN_BLOCK ** -0.5),
        'rg_b_a': nrm(ks[15], (N_RG, 2, D_RNN), 0.02),
        'rg_w_i': nrm(ks[16], (N_RG, 2, N_RNN_BLOCKS, RNN_BLOCK, RNN_BLOCK), RNN_BLOCK ** -0.5),
        'rg_b_i': nrm(ks[17], (N_RG, 2, D_RNN), 0.02),
        'rg_lambda': jnp.log(s) - jnp.log1p(-s),
        'rg_w_out': nrm(ks[19], (N_RG, D_RNN, D), D_RNN ** -0.5),
        'ffn_w_up': nrm(ks[20], (DEPTH, D, 2 * D_FF), D ** -0.5),
        'ffn_conv_w': nrm(ks[21], (DEPTH, FFN_CONV_W, 2 * D_FF), FFN_CONV_W ** -0.5),
        'ffn_conv_b': nrm(ks[22], (DEPTH, 2 * D_FF), 0.02),
        'ffn_w_down': nrm(ks[23], (DEPTH, D_FF, D), D_FF ** -0.5),
        'g_final': 1.0 + nrm(ks[24], (D,), 0.02),
    }


def reference(x, c, ctx, c_ctx, w_mod, b_mod, g_mix, g_ffn, fa_w_in, fa_w_out, attn_sink,
              rg_w_in, rg_conv_w, rg_conv_b, rg_w_a, rg_b_a, rg_w_i, rg_b_i, rg_lambda, rg_w_out,
              ffn_w_up, ffn_conv_w, ffn_conv_b, ffn_w_down, g_final):
    n = x.shape[1]
    rows = n // GRID_W
    row_ids = jnp.repeat(jnp.arange(rows, dtype=jnp.int32), GRID_W)
    col_ids = jnp.tile(jnp.arange(GRID_W, dtype=jnp.int32), rows)
    x_lat, x_ctx = x, ctx
    s_lat = jax.nn.silu(c)
    s_ctx = jax.nn.silu(c_ctx)[None]
    for layer in range(DEPTH):
        ctx_out = layer < DEPTH - 1
        mod_lat = (s_lat @ w_mod[layer] + b_mod[layer])[:, None, :]
        mod_ctx = (s_ctx @ w_mod[layer] + b_mod[layer])[:, None, :]
        sh_m, sc_m, gt_m, sh_f, sc_f, gt_f = jnp.split(mod_lat, N_MOD, axis=-1)
        csh_m, csc_m, cgt_m, csh_f, csc_f, cgt_f = jnp.split(mod_ctx, N_MOD, axis=-1)
        h_lat = modulate(rmsnorm(x_lat, g_mix[layer]), sh_m, sc_m)
        h_ctx = modulate(rmsnorm(x_ctx, g_mix[layer]), csh_m, csc_m)
        i = layer // 2
        if layer % 2 == 0:
            y_lat, y_ctx = fourier_attn_mixer(h_lat, h_ctx, fa_w_in[i], fa_w_out[i], attn_sink[i],
                                              row_ids, col_ids, ctx_out)
        else:
            y_lat, y_ctx = rglru_mixer(h_lat, h_ctx, rg_w_in[i], rg_conv_w[i], rg_conv_b[i], rg_w_a[i], rg_b_a[i],
                                       rg_w_i[i], rg_b_i[i], rg_lambda[i], rg_w_out[i], ctx_out)
        x_lat = x_lat + gt_m * y_lat
        h_lat = modulate(rmsnorm(x_lat, g_ffn[layer]), sh_f, sc_f)
        x_lat = x_lat + gt_f * conv_ffn(h_lat, ffn_w_up[layer], ffn_conv_w[layer], ffn_conv_b[layer], ffn_w_down[layer])
        if ctx_out:
            x_ctx = x_ctx + cgt_m * y_ctx
            h_ctx = modulate(rmsnorm(x_ctx, g_ffn[layer]), csh_f, csc_f)
            x_ctx = x_ctx + cgt_f * conv_ffn(h_ctx, ffn_w_up[layer], ffn_conv_w[layer], ffn_conv_b[layer], ffn_w_down[layer])
    return rmsnorm(x_lat, g_final)
```

```cpp
#include <hip/hip_runtime.h>
#include <cstdio>
#include <cstdint>
#include <cmath>

#ifndef PROBE
#define PROBE 0
#endif
#ifndef MK_ONE_LAUNCH
#define MK_ONE_LAUNCH 1
#endif

namespace pg8 {
#define PG8_LAS __attribute__((address_space(3)))
typedef unsigned short bf16_t;
typedef short bf16x8 __attribute__((ext_vector_type(8)));
typedef float f32x4 __attribute__((ext_vector_type(4)));
typedef unsigned u32x4 __attribute__((ext_vector_type(4)));
typedef unsigned u32x2 __attribute__((ext_vector_type(2)));
constexpr int BM = 256, BK = 64, HALF = 128, HTB = HALF * BK * 2, STAGE_BYTES = 8 * HTB, NXCD = 8, WGM = 4;

__host__ __device__ __forceinline__ int lds_byte(int r, int c) { const int st = (r >> 4) * 2 + (c >> 5), rr = r & 15, cc = c & 31, ob = rr * 64 + cc * 2; return st * 1024 + (ob ^ (((ob >> 9) & 1) << 5)); }
__host__ __device__ __forceinline__ void stage_rc(int b, int& R, int& C) { const int st = b / 1024, sb = b % 1024, swz = sb ^ (((sb >> 9) & 1) << 5); R = (st >> 1) * 16 + swz / 64; C = (st & 1) * 32 + (swz % 64) / 2; }
__host__ __device__ __forceinline__ int perm32(int rho) { const int n = rho >> 4, i = rho & 15; return 8 * (i >> 2) + 4 * n + (i & 3); }

struct Unit { int pm, pn, pb, k0, nt, ks, par; };
struct Gemm { const bf16_t* A; const bf16_t* Bt; int lda, ldb, K; long sA, sB;
    int rmB; long hsB, tsB, tsA; };
__device__ __forceinline__ Gemm mk_gemm(const bf16_t* A, const bf16_t* Bt, int lda, int ldb, int K, long sA, long sB) { Gemm g; g.A = A; g.Bt = Bt; g.lda = lda; g.ldb = ldb; g.K = K; g.sA = sA; g.sB = sB; g.rmB = 1; g.hsB = (long)HALF * ldb * 2; g.tsB = 2 * g.hsB; g.tsA = (long)BM * lda * 2; return g; }

template <bool SPLIT> struct OrderT {
    int nM, nN, nB, nwg, G, c, ntf;
    int nx, xpm, xN, xK, xpb;
    __device__ __forceinline__ void init(int nM_, int nN_, int nB_, int G_, int c_, int K_) { nM = nM_; nN = nN_; nB = nB_; nwg = nM * nN * nB; G = G_; c = c_; ntf = K_ / BK; nx = 0; xpm = 0; xN = 1; xK = 0; xpb = 0; }
    __device__ __forceinline__ void extra(int nslices, int pm_, int nN_, int K_, int pb_ = 0) { nx = nslices * nN_; xpm = pm_; xN = nN_; xK = K_; xpb = pb_; }
    __device__ __forceinline__ bool next(int i, Unit& u) const {
        const long L = (long)i * G + c; if (L >= nwg + (SPLIT ? nx : 0)) return false;
        const bool ex = SPLIT && L >= nwg;
        const int sidx = ex ? (int)L - nwg : 0;
        int wgid = ex ? 0 : (int)L; { const int q = nwg / NXCD, r = nwg % NXCD, xcd = wgid % NXCD, off = wgid / NXCD; wgid = (xcd < r ? xcd * (q + 1) : r * (q + 1) + (xcd - r) * q) + off; }
        const int per = nM * nN; const int pb_ = wgid / per; const int w = wgid % per;
        const int nig = WGM * nN, gid = w / nig, fm = gid * WGM, gsz = (nM - fm) < WGM ? (nM - fm) : WGM;
        const int pm_ = fm + ((w % nig) % gsz), pn_ = (w % nig) / gsz;
        const int xn = SPLIT ? xN : 1;
        u.pm = ex ? xpm : pm_; u.pn = ex ? sidx % xn : pn_; u.pb = ex ? (SPLIT ? xpb : 0) : pb_;
        u.ks = ex ? sidx / xn : -1; u.k0 = ex ? (sidx / xn) * xK : 0; u.nt = ex ? xK / BK : ntf;
        return true;
    }
};
typedef OrderT<false> Order; typedef OrderT<true> OrderSplit;

__device__ __forceinline__ unsigned cvt_pk_bf16(float lo, float hi) { unsigned r; asm volatile("v_cvt_pk_bf16_f32 %0, %1, %2" : "=v"(r) : "v"(lo), "v"(hi)); return r; }

template <class Epi> __device__ __forceinline__ constexpr auto permA_sel(int R, int) -> decltype(Epi::PERMA, int()) { return Epi::PERMA ? ((R & ~63) | ((R & 15) << 2) | ((R >> 4) & 3)) : R; }
template <class Epi> __device__ __forceinline__ constexpr int permA_sel(int R, long) { return R; }
template <class Epi> __device__ __forceinline__ constexpr int permA(int R) { return permA_sel<Epi>(R, 0); }
template <class Epi> __device__ __forceinline__ constexpr auto has_pref(int) -> decltype(Epi::PREFETCH, bool()) { return Epi::PREFETCH; }
template <class Epi> __device__ __forceinline__ constexpr bool has_pref(long) { return false; }
template <class Epi, bool ALIGN_EPI, class Sched>
__device__ __forceinline__ void gemm_phase(PG8_LAS unsigned char* lds, const Gemm g, const Sched& S, const Epi& E, int wv) {
    int lz = 0; asm volatile("" : "+v"(lz)); const int lane = (int)__builtin_amdgcn_mbcnt_hi(~0u, __builtin_amdgcn_mbcnt_lo(~0u, (unsigned)lz)), tid = wv * 64 + lane;
    const int wid = wv, wr = wid >> 2, wc = wid & 3, fr = lane & 15, fq = lane >> 4;
    const __attribute__((address_space(1))) bf16_t* gAg = (const __attribute__((address_space(1))) bf16_t*)g.A; const __attribute__((address_space(1))) bf16_t* gBg = (const __attribute__((address_space(1))) bf16_t*)g.Bt; asm volatile("" : "+s"(gAg), "+s"(gBg));
    const bf16_t* gA = (const bf16_t*)gAg; const bf16_t* gB = (const bf16_t*)gBg;
    unsigned voffA[2], voffB[2];
#pragma unroll
    for (int i = 0; i < 2; ++i) { int R, C; stage_rc(tid * 16 + i * 8192, R, C); const int Rb = Epi::PERM ? ((R & ~31) + perm32(R & 31)) : R;
        const int Ra = permA<Epi>(R); voffA[i] = (unsigned)(Ra * g.lda + C) * 2u; voffB[i] = (unsigned)(Rb * g.rmB * g.ldb + C) * 2u; }
    const size_t kstep = (size_t)(BK * 2);
    const size_t hstepA = (size_t)HALF * g.lda * 2, hstepB = (size_t)g.hsB;
    const unsigned ldsw = (unsigned)wid * 1024u;
    const int aoff = lds_byte(wr * 64 + fr, fq * 8), boff = lds_byte(wc * 32 + fr, fq * 8);
#define PG8_SA(b, h) (((b) * 2 + (h)) * HTB)
#define PG8_SB(b, h) ((4 + (b) * 2 + (h)) * HTB)
#define PG8_STAGE(bufoff, gbase, voff) do { _Pragma("unroll") for (int _i = 0; _i < 2; ++_i) { unsigned _v = (voff)[_i]; asm volatile("" : "+v"(_v));   \
        __builtin_amdgcn_global_load_lds((const unsigned*)((const char*)(gbase) + _v), (PG8_LAS unsigned*)(lds + (bufoff) + ldsw + _i * 8192), 16, 0, 0); } } while (0)
#define PG8_LDA(dst, b, h) do { _Pragma("unroll") for (int m = 0; m < 4; ++m) _Pragma("unroll") for (int k = 0; k < 2; ++k) dst[m][k] = *(const PG8_LAS bf16x8*)(lds + PG8_SA(b, h) + aoff + m * 2048 + k * 1024); } while (0)
#define PG8_LDB(dst, b, h) do { _Pragma("unroll") for (int n = 0; n < 2; ++n) _Pragma("unroll") for (int k = 0; k < 2; ++k) dst[n][k] = *(const PG8_LAS bf16x8*)(lds + PG8_SB(b, h) + boff + n * 2048 + k * 1024); } while (0)
#define PG8_MMA(ai, bj, At, Bt) do { __builtin_amdgcn_s_setprio(1); _Pragma("unroll") for (int m = 0; m < 4; ++m) _Pragma("unroll") for (int n = 0; n < 2; ++n) _Pragma("unroll") for (int k = 0; k < 2; ++k) \
        acc[ai][bj][m][n] = __builtin_amdgcn_mfma_f32_16x16x32_bf16(Bt[n][k], At[m][k], acc[ai][bj][m][n], 0, 0, 0); __builtin_amdgcn_s_setprio(0); } while (0)
#define PG8_WAIT_V(n) asm volatile("s_waitcnt vmcnt(" #n ")" ::: "memory")
#define PG8_WAIT_L(n) asm volatile("s_waitcnt lgkmcnt(" #n ")" ::: "memory")
#define PG8_BAR __builtin_amdgcn_s_barrier()
#define PG8_SCHED __builtin_amdgcn_sched_barrier(0)
    auto PG8_WR = [&]() { int w_ = wr; asm volatile("" : "+s"(w_)); return w_; };
    Unit cur, nxt; int ui = 0;
    if (!S.next(0, cur)) return;
    f32x4 acc[2][2][4][2];
#pragma unroll
    for (int a = 0; a < 2; ++a)
#pragma unroll
        for (int b = 0; b < 2; ++b)
#pragma unroll
            for (int m = 0; m < 4; ++m)
#pragma unroll
                for (int n = 0; n < 2; ++n) acc[a][b][m][n] = (f32x4){0.f, 0.f, 0.f, 0.f};
    bf16x8 At[4][2], B0[2][2], B1[2][2];
    const char* cA = (const char*)(gA + (size_t)cur.pb * g.sA + cur.k0) + (size_t)cur.pm * g.tsA;
    const char* cB = (const char*)(gB + (size_t)cur.pb * g.sB + cur.k0) + (size_t)cur.pn * g.tsB;
    if constexpr (has_pref<Epi>(0)) E.prefetch(cur, 0, wid, lane);
    PG8_STAGE(PG8_SB(0, 0), cB, voffB); PG8_STAGE(PG8_SB(0, 1), cB + hstepB, voffB); PG8_STAGE(PG8_SA(0, 0), cA, voffA); PG8_STAGE(PG8_SA(0, 1), cA + hstepA, voffA);
    if (PG8_WR() == 1) PG8_BAR;
    PG8_WAIT_V(2); PG8_BAR;
    PG8_STAGE(PG8_SB(1, 0), cB + kstep, voffB); PG8_STAGE(PG8_SA(1, 0), cA + kstep, voffA); PG8_STAGE(PG8_SB(1, 1), cB + hstepB + kstep, voffB);
    PG8_WAIT_V(6); PG8_BAR;
    for (;;) {
        const bool has_next = S.next(ui + 1, nxt);
        const char* nA = has_next ? (const char*)(gA + (size_t)nxt.pb * g.sA + nxt.k0) + (size_t)nxt.pm * g.tsA : cA;
        const char* nB = has_next ? (const char*)(gB + (size_t)nxt.pb * g.sB + nxt.k0) + (size_t)nxt.pn * g.tsB : cB;
        int nt = __builtin_amdgcn_readfirstlane(cur.nt); asm volatile("" : "+s"(nt));
        for (int t = 0; t < nt; t += 2) {
            const bool last = (t == nt - 2);
            const char* a1 = cA + (size_t)(t + 1) * kstep;
            const char* a2 = last ? nA : cA + (size_t)(t + 2) * kstep; const char* b2 = last ? nB : cB + (size_t)(t + 2) * kstep;
            const char* a3 = a2 + kstep; const char* b3 = b2 + kstep;
            PG8_LDB(B0, 0, 0); PG8_LDB(B1, 0, 1); PG8_SCHED; PG8_LDA(At, 0, 0); PG8_STAGE(PG8_SA(1, 1), a1 + hstepA, voffA);
            PG8_WAIT_V(8); PG8_WAIT_L(0); PG8_BAR; PG8_MMA(0, 0, At, B0); PG8_MMA(0, 1, At, B1); PG8_BAR; PG8_SCHED;
            PG8_LDA(At, 0, 1); PG8_STAGE(PG8_SB(0, 0), b2, voffB); PG8_STAGE(PG8_SB(0, 1), b2 + hstepB, voffB); PG8_STAGE(PG8_SA(0, 0), a2, voffA);
            PG8_WAIT_V(8); PG8_WAIT_L(0); PG8_BAR; PG8_MMA(1, 0, At, B0); PG8_MMA(1, 1, At, B1); PG8_BAR; PG8_SCHED;
            PG8_LDB(B0, 1, 0); PG8_LDB(B1, 1, 1); PG8_SCHED; PG8_LDA(At, 1, 0); PG8_STAGE(PG8_SA(0, 1), a2 + hstepA, voffA);
            PG8_WAIT_V(8); PG8_WAIT_L(0); PG8_BAR; PG8_MMA(0, 0, At, B0); PG8_MMA(0, 1, At, B1); PG8_BAR; PG8_SCHED;
            PG8_LDA(At, 1, 1); PG8_STAGE(PG8_SB(1, 0), b3, voffB); PG8_STAGE(PG8_SB(1, 1), b3 + hstepB, voffB); PG8_STAGE(PG8_SA(1, 0), a3, voffA);
            PG8_WAIT_V(8); PG8_WAIT_L(0); PG8_BAR; PG8_MMA(1, 0, At, B0); PG8_MMA(1, 1, At, B1); PG8_BAR; PG8_SCHED;
        }
        if constexpr (ALIGN_EPI) { if (PG8_WR() == 0) PG8_BAR; }
        { int fr2 = fr, fq2 = fq; asm volatile("" : "+v"(fr2), "+v"(fq2)); cur.par = ui & 1; E(acc, cur, wr, wc, fr2, fq2); }
        if constexpr (has_pref<Epi>(0)) { if (has_next) E.prefetch(nxt, (ui + 1) & 1, wid, lane); }
        if (!has_next) break;
#pragma unroll
        for (int a = 0; a < 2; ++a)
#pragma unroll
            for (int b = 0; b < 2; ++b)
#pragma unroll
                for (int m = 0; m < 4; ++m)
#pragma unroll
                    for (int n = 0; n < 2; ++n) acc[a][b][m][n] = (f32x4){0.f, 0.f, 0.f, 0.f};
        cur = nxt; cA = nA; cB = nB; ++ui;
        if constexpr (ALIGN_EPI) { if (PG8_WR() == 1) PG8_BAR; }
    }
    PG8_WAIT_V(0);
    if constexpr (!ALIGN_EPI) { if (PG8_WR() == 0) PG8_BAR; }
    PG8_BAR;
#undef PG8_SA
#undef PG8_SB
#undef PG8_STAGE
#undef PG8_LDA
#undef PG8_LDB
#undef PG8_MMA
#undef PG8_WAIT_V
#undef PG8_WAIT_L
#undef PG8_BAR
#undef PG8_SCHED
}
}

constexpr float LOG2E = 1.4426950408889634f;
constexpr int NWAVES = 8, NTHR = NWAVES * 64;
constexpr int D = 2048, SEQ = 8192, CTXL = 256, MT = SEQ + CTXL, DEPTH = 4;
constexpr int FA_IN = 2304, DFF = 5632, DFF2 = 11264, NMOD6 = 6 * D;
constexpr float EPS = 1e-6f;

constexpr size_t MiB = 1u << 20;
constexpr size_t WS_CTL = 0, CTL_ZERO_BYTES = 1 * MiB;
constexpr size_t WS_MODP = 364 * MiB;
constexpr size_t WS_MOD = 4 * MiB;
constexpr size_t WS_ROPE = 5 * MiB;
constexpr size_t WS_SP8 = 5 * MiB + 65536;
constexpr size_t WS_DFTC = 6 * MiB;
constexpr size_t WS_DFTNC = 7 * MiB;
constexpr size_t WS_DA = 7 * MiB + 262144;
constexpr size_t WS_DB4 = 7 * MiB + 393216;
constexpr size_t WS_TW = 7 * MiB + 655360;
constexpr size_t WS_SCAN = 1212 * MiB;
constexpr size_t WS_WGATE = 10 * MiB;
constexpr size_t WS_WINFA = 18 * MiB;
constexpr size_t WS_WOUTFA = 36 * MiB;
constexpr size_t WS_WINRG = 52 * MiB;
constexpr size_t WS_WOUTRG = 84 * MiB;
constexpr size_t WS_WUP = 100 * MiB;
constexpr size_t WS_WDOWN = 276 * MiB;
constexpr size_t WS_DFTN = 364 * MiB;
constexpr size_t WS_X = 620 * MiB;
constexpr size_t WS_H = 686 * MiB;
constexpr size_t WS_TMP = 719 * MiB;
constexpr size_t WS_U = WS_TMP, WS_ACT = 901 * MiB;
constexpr size_t WS_LG = WS_TMP;
constexpr size_t WS_F = WS_TMP, WS_Q = 736 * MiB, WS_KB = 753 * MiB, WS_VB = 756 * MiB, WS_VT = 759 * MiB, WS_VTC = 791 * MiB, WS_ZP = 792 * MiB;
constexpr size_t WS_Z = 992 * MiB;
constexpr size_t WS_GATE = 1025 * MiB;
constexpr size_t WS_XS = 1058 * MiB;
constexpr size_t WS_XSC = 1091 * MiB;
constexpr size_t WS_HF = 1124 * MiB;
constexpr size_t WS_PART = 1190 * MiB;
constexpr size_t WS_PART2 = 1220 * MiB;
constexpr size_t WS_END = 1254 * MiB;
constexpr int CW_BAR = 4096;
constexpr int CW_BGT = 8192, CW_BGM = 8704;

constexpr int RING_BYTES = 131072;
constexpr int MISC_OFF = RING_BYTES + 320, PTAB_OFF = RING_BYTES + 1024, EX_OFF = RING_BYTES + 4096, WB_OFF = RING_BYTES + 12288;
constexpr int LDS_BYTES = 151552;

#define GAS __attribute__((address_space(1)))
#define LAS __attribute__((address_space(3)))
typedef unsigned short bf16;
typedef unsigned v4u __attribute__((ext_vector_type(4)));
typedef unsigned v2u __attribute__((ext_vector_type(2)));
typedef float f32x4 __attribute__((ext_vector_type(4)));
typedef float f32x16 __attribute__((ext_vector_type(16)));
typedef short bf16x8 __attribute__((ext_vector_type(8)));
typedef short s16x4 __attribute__((ext_vector_type(4)));
typedef GAS unsigned gu32;

__device__ __forceinline__ int otid(int wv) { int z = 0; asm volatile("" : "+v"(z)); return wv * 64 + (int)__builtin_amdgcn_mbcnt_hi(~0u, __builtin_amdgcn_mbcnt_lo(~0u, (unsigned)z)); }
__device__ __forceinline__ int obid() { int b = blockIdx.x; asm volatile("" : "+s"(b)); return b; }
__device__ __forceinline__ int ogrid() { int b = gridDim.x; asm volatile("" : "+s"(b)); return b; }
__device__ __forceinline__ bool in_range(int lo, int hi, int k) { asm volatile("" : "+s"(lo), "+s"(hi)); return lo <= k && k < hi; }
__device__ __forceinline__ unsigned f2bf(float f) { unsigned u = __builtin_bit_cast(unsigned, f); return (u + 0x7fffu + ((u >> 16) & 1u)) >> 16; }
__device__ __forceinline__ unsigned pk2(float lo, float hi) { unsigned r; asm("v_cvt_pk_bf16_f32 %0, %1, %2" : "=v"(r) : "v"(lo), "v"(hi)); return r; }
__device__ __forceinline__ float bflo(unsigned w) { return __builtin_bit_cast(float, w << 16); }
__device__ __forceinline__ float bfhi(unsigned w) { return __builtin_bit_cast(float, w & 0xffff0000u); }
__device__ __forceinline__ float bf2f(bf16 h) { return __builtin_bit_cast(float, (unsigned)h << 16); }
__device__ __forceinline__ float lane_xor(float v, int lane, int o) { return __builtin_bit_cast(float, __builtin_amdgcn_ds_bpermute((lane ^ o) << 2, __builtin_bit_cast(int, v))); }
__device__ __forceinline__ float wave_sum(float v, int lane) {
#pragma unroll
    for (int o = 1; o < 64; o <<= 1) v += lane_xor(v, lane, o);
    return v;
}
__device__ __forceinline__ float fexp(float x) { return __builtin_amdgcn_exp2f(x * 1.4426950408889634f); }
__device__ __forceinline__ float frcp(float x) { return __builtin_amdgcn_rcpf(x); }
__device__ __forceinline__ float sigmoidf_(float x) { return frcp(1.0f + fexp(-x)); }
__device__ __forceinline__ float siluf_(float x) { return x * frcp(1.0f + fexp(-x)); }
__device__ __forceinline__ float gelu_tanh(float x) { const float u = 0.7978845608028654f * (x + 0.044715f * x * x * x); return x * frcp(1.0f + fexp(-2.0f * u)); }

#define XB_TMO      128
#define XB_XCNT(j)  (256  + 64 * (j))
#define XB_XSUB(j)  (1280 + 64 * (j))
#define XB_XGEN(j)  (2304 + 64 * (j))
#define XB_TOP      3328
#define XB_TOPGEN   3392
#define XCD_BAR_WORDS 3456
#define XB_SPIN_CAP (1u << 18)
__device__ __forceinline__ unsigned xb_ld(unsigned* p)              { return __hip_atomic_load(p, __ATOMIC_RELAXED, __HIP_MEMORY_SCOPE_AGENT); }
__device__ __forceinline__ unsigned xb_add(unsigned* p, unsigned v) { return __hip_atomic_fetch_add(p, v, __ATOMIC_RELAXED, __HIP_MEMORY_SCOPE_AGENT); }
__device__ __forceinline__ unsigned xb_xcc_id() { return (unsigned)__builtin_amdgcn_s_getreg((3 << 11) | 20) & 0xFu; }
#define XB_SPIN(cond, bar) do { unsigned _sp = 0; while (cond) { __builtin_amdgcn_s_sleep(1); \
    if ((++_sp & 255u) == 0u) { if (xb_ld(&(bar)[XB_TMO])) break; if (_sp > XB_SPIN_CAP) { atomicAdd(&(bar)[XB_TMO], 1u); break; } } } } while (0)
struct XcdBarrier { unsigned* bar; unsigned x; volatile LAS unsigned* st; };
__device__ __forceinline__ XcdBarrier xcd_barrier_post(unsigned* bar, volatile LAS unsigned* st) {
    XcdBarrier b; b.bar = bar; b.x = xb_xcc_id(); b.st = st;
    if (threadIdx.x == 0) (void)xb_add(&bar[XB_XCNT(b.x)], 1u);
    return b;
}
__device__ __forceinline__ void xcd_barrier_complete(unsigned* bar, unsigned x, unsigned& nloc, unsigned& nx) {
    const unsigned G = gridDim.x * gridDim.y * gridDim.z;
    unsigned sum, cnt, mine, sp = 0u;
    for (;;) {
        sum = 0u; cnt = 0u; mine = 0u;
#pragma unroll
        for (unsigned j = 0; j < 16; ++j) { const unsigned c = xb_ld(&bar[XB_XCNT(j)]); sum += c; cnt += (c > 0u) ? 1u : 0u; mine = (j == x) ? c : mine; }
        if (sum == G) break;
        __builtin_amdgcn_s_sleep(1);
        if ((++sp & 255u) == 0u) { if (xb_ld(&bar[XB_TMO])) break; if (sp > XB_SPIN_CAP) { atomicAdd(&bar[XB_TMO], 1u); break; } }
    }
    nloc = mine > 0u ? mine : 1u; nx = cnt > 0u ? cnt : 1u;
}
__device__ __forceinline__ void xcd_barrier(const XcdBarrier& b, int wv) {
    asm volatile("s_waitcnt vmcnt(0)" ::: "memory");
    __syncthreads();
    unsigned bx = b.x; asm volatile("" : "+v"(bx));
    if (otid(wv) == 0) {
        unsigned* bar = b.bar;
        __builtin_amdgcn_s_waitcnt(0);
        unsigned nloc = b.st[0], nx = b.st[1];
        if (nloc == 0u) { xcd_barrier_complete(bar, bx, nloc, nx); b.st[0] = nloc; b.st[1] = nx; }
        const unsigned old = xb_add(&bar[XB_XSUB(bx)], 1u);
        const unsigned gen = old / nloc;
        if (old + 1u == (gen + 1u) * nloc) {
            __builtin_amdgcn_fence(__ATOMIC_RELEASE, "agent");
            asm volatile("s_waitcnt vmcnt(0)" ::: "memory");
            const unsigned og = xb_add(&bar[XB_TOP], 1u);
            const unsigned tg = og / nx;
            if (og + 1u == (tg + 1u) * nx) xb_add(&bar[XB_TOPGEN], 1u);
            else XB_SPIN(xb_ld(&bar[XB_TOPGEN]) == tg, bar);
            __builtin_amdgcn_fence(__ATOMIC_ACQUIRE, "agent");
            xb_add(&bar[XB_XGEN(bx)], 1u);
            asm volatile("s_waitcnt vmcnt(0)" ::: "memory");
        } else {
            XB_SPIN(xb_ld(&bar[XB_XGEN(bx)]) == gen, bar);
            __builtin_amdgcn_fence(__ATOMIC_ACQUIRE, "agent");
            asm volatile("s_waitcnt vmcnt(0)" ::: "memory");
        }
    }
    __syncthreads();
}

using pg8::Unit;
struct EpiStore {
    static constexpr bool PERM = true;
    bf16* O; int ldc; long sC; int split_tiles; long split_stride; float scale;
    __device__ __forceinline__ void operator()(const f32x4 (&acc)[2][2][4][2], const Unit& u, int wr, int wc, int fr, int fq) const {
        const int row0 = u.pm * 256 + wr * 64 + fr; int pn = u.pn; bf16* base = O + (size_t)u.pb * sC;
        if (split_tiles) { const int t = pn / split_tiles; base += (size_t)t * split_stride; pn -= t * split_tiles; }
        const int col0 = pn * 256 + wc * 32 + 8 * fq;
#pragma unroll
        for (int ai = 0; ai < 2; ++ai)
#pragma unroll
            for (int m = 0; m < 4; ++m) { bf16* rowp = base + (size_t)(row0 + ai * 128 + m * 16) * ldc + col0;
#pragma unroll
                for (int bj = 0; bj < 2; ++bj) { const f32x4 v0 = acc[ai][bj][m][0] * scale, v1 = acc[ai][bj][m][1] * scale;
                    v4u w; w.x = pg8::cvt_pk_bf16(v0[0], v0[1]); w.y = pg8::cvt_pk_bf16(v0[2], v0[3]); w.z = pg8::cvt_pk_bf16(v1[0], v1[1]); w.w = pg8::cvt_pk_bf16(v1[2], v1[3]);
                    *(v4u*)(rowp + bj * 128) = w; } }
    }
};
struct EpiRgIn {
    static constexpr bool PERM = true;
    bf16* GATE; bf16* XS; float* PART2;
    __device__ __forceinline__ void operator()(const f32x4 (&acc)[2][2][4][2], const Unit& u, int wr, int wc, int fr, int fq) const {
        if (u.ks >= 0) {
            const int col0 = u.pn * 256 + wc * 32 + 8 * fq;
#pragma unroll
            for (int ai = 0; ai < 2; ++ai)
#pragma unroll
                for (int m = 0; m < 4; ++m) { float* p = PART2 + ((size_t)u.ks * 256 + ai * 128 + wr * 64 + m * 16 + fr) * 4096 + col0;
#pragma unroll
                    for (int bj = 0; bj < 2; ++bj) { *(f32x4*)(p + bj * 128) = acc[ai][bj][m][0]; *(f32x4*)(p + bj * 128 + 4) = acc[ai][bj][m][1]; } }
            return;
        }
        const int row0 = u.pm * 256 + wr * 64 + fr; bf16* base = u.pn < 8 ? GATE : XS; const int col0 = (u.pn & 7) * 256 + wc * 32 + 8 * fq;
#pragma unroll
        for (int ai = 0; ai < 2; ++ai)
#pragma unroll
            for (int m = 0; m < 4; ++m) { bf16* rowp = base + (size_t)(row0 + ai * 128 + m * 16) * D + col0;
#pragma unroll
                for (int bj = 0; bj < 2; ++bj) { const f32x4 v0 = acc[ai][bj][m][0], v1 = acc[ai][bj][m][1];
                    v4u w; w.x = pg8::cvt_pk_bf16(v0[0], v0[1]); w.y = pg8::cvt_pk_bf16(v0[2], v0[3]); w.z = pg8::cvt_pk_bf16(v1[0], v1[1]); w.w = pg8::cvt_pk_bf16(v1[2], v1[3]);
                    *(v4u*)(rowp + bj * 128) = w; } }
    }
};
struct EpiX3 {
    static constexpr bool PERM = true;
    bf16* X3;
    __device__ __forceinline__ void operator()(const f32x4 (&acc)[2][2][4][2], const Unit& u, int wr, int wc, int fr, int fq) const {
#pragma unroll
        for (int ai = 0; ai < 2; ++ai)
#pragma unroll
            for (int m = 0; m < 4; ++m) { const int r = u.pm * 256 + ai * 128 + wr * 64 + m * 16 + fr; const int mch = r >> 1, sgn = r & 1;
#pragma unroll
                for (int bj = 0; bj < 2; ++bj) { const int n2 = 2 * u.pn + bj, n1 = wc * 32 + 8 * fq;
                    bf16* dst = X3 + ((size_t)((u.pb * 256 + mch) * 64 + n2)) * 256 + sgn * 128 + n1;
                    const f32x4 v0 = acc[ai][bj][m][0], v1 = acc[ai][bj][m][1];
                    v4u w; w.x = pg8::cvt_pk_bf16(v0[0], v0[1]); w.y = pg8::cvt_pk_bf16(v0[2], v0[3]); w.z = pg8::cvt_pk_bf16(v1[0], v1[1]); w.w = pg8::cvt_pk_bf16(v1[2], v1[3]);
                    *(v4u*)dst = w; } }
    }
};
struct EpiTw {
    static constexpr bool PERM = true;
    bf16* ZP; const float* twc; const float* tws;
    __device__ __forceinline__ void operator()(const f32x4 (&acc)[2][2][4][2], const Unit& u, int wr, int wc, int fr, int fq) const {
        f32x4 cw[4][2][2], sw[4][2][2];
#pragma unroll
        for (int m = 0; m < 4; ++m) { const int k1 = wr * 64 + m * 16 + fr;
#pragma unroll
            for (int bj = 0; bj < 2; ++bj) { const int n2 = (bj * 128 + wc * 32 + 8 * fq) & 63;
                cw[m][bj][0] = *(const f32x4*)(twc + k1 * 64 + n2); cw[m][bj][1] = *(const f32x4*)(twc + k1 * 64 + n2 + 4);
                sw[m][bj][0] = *(const f32x4*)(tws + k1 * 64 + n2); sw[m][bj][1] = *(const f32x4*)(tws + k1 * 64 + n2 + 4); } }
#pragma unroll
        for (int m = 0; m < 4; ++m) { const int k1 = wr * 64 + m * 16 + fr;
#pragma unroll
            for (int bj = 0; bj < 2; ++bj) { const int colg = u.pn * 256 + bj * 128 + wc * 32 + 8 * fq; const int gm = colg >> 6, n2 = colg & 63;
                bf16* dst = ZP + ((size_t)gm * 128 + k1) * 128 + n2;
                v4u wr_, wi_;
#pragma unroll
                for (int n = 0; n < 2; ++n) { const f32x4 zr = acc[0][bj][m][n], zi = acc[1][bj][m][n], c = cw[m][bj][n], sn = sw[m][bj][n];
                    const f32x4 yr = zr * c + zi * sn, yi = zi * c - zr * sn;
                    if (n == 0) { wr_.x = pg8::cvt_pk_bf16(yr[0], yr[1]); wr_.y = pg8::cvt_pk_bf16(yr[2], yr[3]); wi_.x = pg8::cvt_pk_bf16(yi[0], yi[1]); wi_.y = pg8::cvt_pk_bf16(yi[2], yi[3]); }
                    else { wr_.z = pg8::cvt_pk_bf16(yr[0], yr[1]); wr_.w = pg8::cvt_pk_bf16(yr[2], yr[3]); wi_.z = pg8::cvt_pk_bf16(yi[0], yi[1]); wi_.w = pg8::cvt_pk_bf16(yi[2], yi[3]); } }
                *(v4u*)dst = wr_; *(v4u*)(dst + 64) = wi_; } }
    }
};
struct EpiFftOut {
    static constexpr bool PERM = true;
    bf16* Z; float scale;
    __device__ __forceinline__ void operator()(const f32x4 (&acc)[2][2][4][2], const Unit& u, int wr, int wc, int fr, int fq) const {
        const int col0 = u.pn * 256 + wc * 32 + 8 * fq;
#pragma unroll
        for (int ai = 0; ai < 2; ++ai)
#pragma unroll
            for (int m = 0; m < 4; ++m) { const int tok = 4 * u.pb + 2 * ai + wr + 128 * (16 * m + fr); bf16* rowp = Z + (size_t)tok * D + col0;
#pragma unroll
                for (int bj = 0; bj < 2; ++bj) { const f32x4 v0 = acc[ai][bj][m][0] * scale, v1 = acc[ai][bj][m][1] * scale;
                    v4u w; w.x = pg8::cvt_pk_bf16(v0[0], v0[1]); w.y = pg8::cvt_pk_bf16(v0[2], v0[3]); w.z = pg8::cvt_pk_bf16(v1[0], v1[1]); w.w = pg8::cvt_pk_bf16(v1[2], v1[3]);
                    *(v4u*)(rowp + bj * 128) = w; } }
    }
};
template <int CTRL> __device__ __forceinline__ float dpp_zero(float src) { return __builtin_bit_cast(float, __builtin_amdgcn_update_dpp(0, __builtin_bit_cast(int, src), CTRL, 0xf, 0xf, true)); }
template <int CTRL> __device__ __forceinline__ float dpp_mov(float old, float src) { return __builtin_bit_cast(float, __builtin_amdgcn_update_dpp(__builtin_bit_cast(int, old), __builtin_bit_cast(int, src), CTRL, 0xf, 0xf, false)); }
struct EpiConvAct {
    static constexpr bool PERM = true, PERMA = true, PREFETCH = true;
    bf16* ACT; const float* cw; const float* cb; PG8_LAS float* EX; PG8_LAS float* WB;
    __device__ __forceinline__ void prefetch(const Unit& u, int par, int wid, int lane) const {
        if (wid >= 4) return;
        const int a = wid * 2 + (lane >> 5), piece = lane & 31, isv = a >> 2, k = a & 3;
        const float* src = (k < 3 ? cw + (size_t)k * DFF2 : cb) + isv * DFF + u.pn * 128 + piece * 4;
        __builtin_amdgcn_global_load_lds((const unsigned*)src, (PG8_LAS unsigned*)(WB + par * 1024 + wid * 256), 16, 0, 0);
    }
    __device__ __forceinline__ void operator()(const f32x4 (&acc)[2][2][4][2], const Unit& u, int wr, int wc, int fr, int fq) const {
        const bool ctx = u.ks >= 0;
        const int c0 = u.pn * 128 + wc * 32 + 8 * fq;
        const int grow0 = ctx ? SEQ : 254 * u.pm - 1;
#pragma unroll
        for (int ai = 0; ai < 2; ++ai) { const int blk = ai * 2 + wr;
            const bool first = fr == 0;
            if (fr == 0 || fr == 15) { PG8_LAS float* e = EX + ((blk * 4 + wc) * 2 + (first ? 0 : 1)) * 64 + fq * 16;
#pragma unroll
                for (int bj = 0; bj < 2; ++bj)
#pragma unroll
                    for (int n = 0; n < 2; ++n) { const f32x4 a0 = acc[ai][bj][0][n], a3 = acc[ai][bj][3][n]; f32x4 v;
#pragma unroll
                        for (int i = 0; i < 4; ++i) v[i] = first ? a0[i] : a3[i];
                        *(PG8_LAS f32x4*)(e + bj * 8 + 4 * n) = v; } } }
        asm volatile("s_waitcnt lgkmcnt(0)" ::: "memory"); __builtin_amdgcn_s_barrier(); asm volatile("" ::: "memory");
        if (ctx) conv_body<true>(acc, u.par, wr, wc, fr, fq, c0, grow0, 0, 255, 0, 255);
        else if (u.pm == 0) conv_body<true>(acc, u.par, wr, wc, fr, fq, c0, grow0, 1, 1 << 20, 1, 254);
        else if (u.pm == 32) conv_body<true>(acc, u.par, wr, wc, fr, fq, c0, grow0, -(1 << 20), SEQ - 1 - grow0, 1, SEQ - 1 - grow0);
        else conv_body<false>(acc, u.par, wr, wc, fr, fq, c0, grow0, 0, 0, 1, 254);
    }
    template <bool SP> __device__ __forceinline__ void conv_body(const f32x4 (&acc)[2][2][4][2], int par, int wr, int wc, int fr, int fq, int c0, int grow0, int vlo, int vhi, int slo, int shi) const {
        const f32x4 zero4 = (f32x4){0.f, 0.f, 0.f, 0.f};
#pragma unroll
        for (int ai = 0; ai < 2; ++ai) { const int blk = ai * 2 + wr;
            v2u keep[4];
            const int bp = blk > 0 ? blk - 1 : 0, bn = blk < 3 ? blk + 1 : 3;
            const int tb = blk * 64 + 4 * fr;
            bf16* outp = ACT + ((long)grow0 + tb) * DFF + c0;
#pragma unroll
            for (int n = 0; n < 2; ++n) {
                f32x4 w0[2], w1[2], w2[2], bq[2], up[2], dn[2], a[2][4];
#pragma unroll
                for (int bj = 0; bj < 2; ++bj) { const PG8_LAS float* wl = WB + par * 1024 + bj * 512 + wc * 32 + 8 * fq + 4 * n;
                    w0[bj] = *(const PG8_LAS f32x4*)(wl); w1[bj] = *(const PG8_LAS f32x4*)(wl + 128); w2[bj] = *(const PG8_LAS f32x4*)(wl + 256); bq[bj] = *(const PG8_LAS f32x4*)(wl + 384);
                    const f32x4 pe = *(const PG8_LAS f32x4*)(EX + ((bp * 4 + wc) * 2 + 1) * 64 + fq * 16 + bj * 8 + 4 * n);
                    const f32x4 ne = *(const PG8_LAS f32x4*)(EX + ((bn * 4 + wc) * 2 + 0) * 64 + fq * 16 + bj * 8 + 4 * n);
#pragma unroll
                    for (int mm = 0; mm < 4; ++mm) { a[bj][mm] = acc[ai][bj][mm][n]; if (SP) { if (tb + mm < vlo || tb + mm > vhi) a[bj][mm] = zero4; } }
#pragma unroll
                    for (int i = 0; i < 4; ++i) { up[bj][i] = dpp_mov<0x111>(pe[i], a[bj][3][i]); dn[bj][i] = dpp_mov<0x101>(ne[i], a[bj][0][i]); }
                    if (SP) { if (tb - 1 < vlo || tb - 1 > vhi) up[bj] = zero4; if (tb + 4 < vlo || tb + 4 > vhi) dn[bj] = zero4; } }
#pragma unroll
                for (int m = 0; m < 4; ++m) {
                    const f32x4 gm = m == 0 ? up[0] : a[0][m > 0 ? m - 1 : 0], gp = m == 3 ? dn[0] : a[0][m < 3 ? m + 1 : 3];
                    const f32x4 vm = m == 0 ? up[1] : a[1][m > 0 ? m - 1 : 0], vp = m == 3 ? dn[1] : a[1][m < 3 ? m + 1 : 3];
                    const f32x4 yg = bq[0] + w0[0] * gm + w1[0] * a[0][m] + w2[0] * gp;
                    const f32x4 yv = bq[1] + w0[1] * vm + w1[1] * a[1][m] + w2[1] * vp;
                    const f32x4 t = yg * -1.4426950408889634f; f32x4 e;
#pragma unroll
                    for (int i = 0; i < 4; ++i) e[i] = __builtin_amdgcn_exp2f(t[i]);
                    const f32x4 d = e + 1.0f; f32x4 r;
#pragma unroll
                    for (int i = 0; i < 4; ++i) r[i] = __builtin_amdgcn_rcpf(d[i]);
                    const f32x4 o = (yg * yv) * r;
                    v2u w; w.x = pg8::cvt_pk_bf16(o[0], o[1]); w.y = pg8::cvt_pk_bf16(o[2], o[3]);
                    if (n == 0) keep[m] = w;
                    else if (tb + m >= slo && tb + m <= shi) __builtin_nontemporal_store((v4u){keep[m].x, keep[m].y, w.x, w.y}, (v4u*)(outp + (long)m * DFF)); }
            }
        }
    }
};
struct EpiResid {
    static constexpr bool PERM = true;
    bf16* X; const float* gt_lat; const float* gt_ctx; float* PART; const float* Xin32; const bf16* Xin16;
    __device__ __forceinline__ void operator()(const f32x4 (&acc)[2][2][4][2], const Unit& u, int wr, int wc, int fr, int fq) const {
        const float* gt = (u.pm >= 32) ? gt_ctx : gt_lat;
        const int col0 = u.pn * 256 + wc * 32 + 8 * fq;
        if (u.ks >= 0) {
#pragma unroll
            for (int ai = 0; ai < 2; ++ai)
#pragma unroll
                for (int m = 0; m < 4; ++m) { bf16* p = (bf16*)PART + ((size_t)u.ks * 256 + ai * 128 + wr * 64 + m * 16 + fr) * D + col0;
#pragma unroll
                    for (int bj = 0; bj < 2; ++bj) { const f32x4 a = acc[ai][bj][m][0], b = acc[ai][bj][m][1];
                        *(v4u*)(p + bj * 128) = (v4u){pk2(a[0], a[1]), pk2(a[2], a[3]), pk2(b[0], b[1]), pk2(b[2], b[3])}; } }
            return;
        }
        f32x4 gv[2][2];
#pragma unroll
        for (int bj = 0; bj < 2; ++bj)
#pragma unroll
            for (int n = 0; n < 2; ++n) gv[bj][n] = *(const f32x4*)(gt + col0 + bj * 128 + n * 4);
        if (Xin32) {
#pragma unroll
            for (int ai = 0; ai < 2; ++ai) {
                f32x4 xv[4][2][2];
#pragma unroll
                for (int m = 0; m < 4; ++m) { const float* p = Xin32 + (size_t)(u.pm * 256 + ai * 128 + wr * 64 + m * 16 + fr) * D + col0;
#pragma unroll
                    for (int bj = 0; bj < 2; ++bj)
#pragma unroll
                        for (int n = 0; n < 2; ++n) xv[m][bj][n] = *(const f32x4*)(p + bj * 128 + n * 4); }
#pragma unroll
                for (int m = 0; m < 4; ++m) { bf16* p = X + (size_t)(u.pm * 256 + ai * 128 + wr * 64 + m * 16 + fr) * D + col0;
#pragma unroll
                    for (int bj = 0; bj < 2; ++bj) { const f32x4 a = xv[m][bj][0] + gv[bj][0] * acc[ai][bj][m][0], b = xv[m][bj][1] + gv[bj][1] * acc[ai][bj][m][1];
                        *(v4u*)(p + bj * 128) = (v4u){pk2(a[0], a[1]), pk2(a[2], a[3]), pk2(b[0], b[1]), pk2(b[2], b[3])}; } }
            }
        } else {
#pragma unroll
            for (int ai = 0; ai < 2; ++ai) {
                v4u xv[4][2];
#pragma unroll
                for (int m = 0; m < 4; ++m) { const bf16* p = Xin16 + (size_t)(u.pm * 256 + ai * 128 + wr * 64 + m * 16 + fr) * D + col0;
#pragma unroll
                    for (int bj = 0; bj < 2; ++bj) xv[m][bj] = *(const v4u*)(p + bj * 128); }
#pragma unroll
                for (int m = 0; m < 4; ++m) { bf16* p = X + (size_t)(u.pm * 256 + ai * 128 + wr * 64 + m * 16 + fr) * D + col0;
#pragma unroll
                    for (int bj = 0; bj < 2; ++bj) { const v4u x = xv[m][bj];
                        const f32x4 a = (f32x4){bflo(x.x), bfhi(x.x), bflo(x.y), bfhi(x.y)} + gv[bj][0] * acc[ai][bj][m][0], b = (f32x4){bflo(x.z), bfhi(x.z), bflo(x.w), bfhi(x.w)} + gv[bj][1] * acc[ai][bj][m][1];
                        *(v4u*)(p + bj * 128) = (v4u){pk2(a[0], a[1]), pk2(a[2], a[3]), pk2(b[0], b[1]), pk2(b[2], b[3])}; } }
            }
        }
    }
};
struct EpiRope {
    static constexpr bool PERM = false;
    bf16 *F, *Q, *KB, *VB; const float* ropec; const float* ropes;
    __device__ __forceinline__ void operator()(const f32x4 (&acc)[2][2][4][2], const Unit& u, int wr, int wc, int fr, int fq) const {
        const bool lat = u.pm < 32;
        f32x4 csv[2][4], snv[2][4];
#pragma unroll
        for (int ai = 0; ai < 2; ++ai)
#pragma unroll
            for (int m = 0; m < 4; ++m) {
                const int row = u.pm * 256 + ai * 128 + wr * 64 + m * 16 + fr;
                const int pos = (wc & 1) ? (row & 63) : ((row >> 6) & 127);
                csv[ai][m] = (f32x4){1.f, 1.f, 1.f, 1.f}; snv[ai][m] = (f32x4){0.f, 0.f, 0.f, 0.f};
                if (lat && u.pn >= 4) { csv[ai][m] = *(const f32x4*)(ropec + pos * 16 + 4 * fq); snv[ai][m] = *(const f32x4*)(ropes + pos * 16 + 4 * fq); }
            }
#pragma unroll
        for (int ai = 0; ai < 2; ++ai)
#pragma unroll
            for (int m = 0; m < 4; ++m) {
                const int row = u.pm * 256 + ai * 128 + wr * 64 + m * 16 + fr;
                const f32x4 cs = csv[ai][m], sn = snv[ai][m];
#pragma unroll
                for (int bj = 0; bj < 2; ++bj) {
                    const int c0 = u.pn * 256 + bj * 128 + wc * 32;
                    f32x4 x1 = acc[ai][bj][m][0], x2 = acc[ai][bj][m][1];
                    bf16* dst; int ld;
                    if (c0 < 1024) { dst = F + (size_t)row * 1024 + c0; ld = 0; }
                    else if (c0 < 2048) { dst = Q + (size_t)row * 1024 + (c0 - 1024); ld = 1; }
                    else if (c0 < 2176) { dst = KB + (size_t)row * 128 + (c0 - 2048); ld = 2; }
                    else { dst = VB + (size_t)row * 128 + (c0 - 2176); ld = 3; }
                    if (ld == 1 || ld == 2) {
                        const f32x4 y1 = x1 * cs - x2 * sn, y2 = x1 * sn + x2 * cs;
                        x1 = y1; x2 = y2;
                        if (ld == 1) { x1 = x1 * (0.125f * LOG2E); x2 = x2 * (0.125f * LOG2E); }
                    }
                    v2u w1, w2; w1.x = pg8::cvt_pk_bf16(x1[0], x1[1]); w1.y = pg8::cvt_pk_bf16(x1[2], x1[3]); w2.x = pg8::cvt_pk_bf16(x2[0], x2[1]); w2.y = pg8::cvt_pk_bf16(x2[2], x2[3]);
                    *(v2u*)(dst + 4 * fq) = w1; *(v2u*)(dst + 16 + 4 * fq) = w2;
                }
            }
    }
};
struct EpiGates {
    static constexpr bool PERM = true;
    const float *b_a, *b_i, *lam;
    const bf16* XSC; unsigned* LG;
    __device__ __forceinline__ void operator()(const f32x4 (&acc)[2][2][4][2], const Unit& u, int wr, int wc, int fr, int fq) const {
        const int d = u.pn >> 1, half = u.pn & 1;
        const int col0 = u.pb * 256 + half * 128 + wc * 32 + 8 * fq;
        v2u xwv[2][2][4];
#pragma unroll
        for (int n = 0; n < 2; ++n)
#pragma unroll
            for (int ai = 0; ai < 2; ++ai)
#pragma unroll
                for (int m = 0; m < 4; ++m) xwv[n][ai][m] = *(const v2u*)(XSC + (size_t)(u.pm * 256 + ai * 128 + wr * 64 + m * 16 + fr) * D + col0 + n * 4);
#pragma unroll
        for (int n = 0; n < 2; ++n) {
            const f32x4 ba = *(const f32x4*)(b_a + d * D + col0 + n * 4), bi = *(const f32x4*)(b_i + d * D + col0 + n * 4);
            const f32x4 sp = *(const f32x4*)(lam + d * D + col0 + n * 4) * 1.4426950408889634f;
#pragma unroll
            for (int ai = 0; ai < 2; ++ai)
#pragma unroll
                for (int m = 0; m < 4; ++m) { const int row = u.pm * 256 + ai * 128 + wr * 64 + m * 16 + fr;
                    const v2u xw = xwv[n][ai][m];
                    const f32x4 xs = (f32x4){bflo(xw.x), bfhi(xw.x), bflo(xw.y), bfhi(xw.y)};
                    const f32x4 ta = (acc[ai][0][m][n] + ba) * -1.4426950408889634f, ti = (acc[ai][1][m][n] + bi) * -1.4426950408889634f;
                    f32x4 ea, ei;
#pragma unroll
                    for (int i = 0; i < 4; ++i) { ea[i] = __builtin_amdgcn_exp2f(ta[i]); ei[i] = __builtin_amdgcn_exp2f(ti[i]); }
                    const f32x4 da = ea + 1.0f, di = ei + 1.0f, dd = da * di; f32x4 inv;
#pragma unroll
                    for (int i = 0; i < 4; ++i) inv[i] = __builtin_amdgcn_rcpf(dd[i]);
                    const f32x4 l2 = (di * inv) * sp;
                    f32x4 av;
#pragma unroll
                    for (int i = 0; i < 4; ++i) av[i] = __builtin_amdgcn_exp2f(l2[i]);
                    const f32x4 q = 1.0f - av;
                    const f32x4 om = q * (2.0f - q);
                    f32x4 sq;
#pragma unroll
                    for (int i = 0; i < 4; ++i) sq[i] = __builtin_amdgcn_sqrtf(om[i]);
                    const f32x4 gx = sq * ((da * inv) * xs);
                    v4u lg;
#pragma unroll
                    for (int i = 0; i < 4; ++i) lg[i] = pg8::cvt_pk_bf16(q[i], gx[i]);
                    const size_t o = ((size_t)d * MT + row) * D + col0 + n * 4;
                    *(v4u*)(LG + o) = lg;
                }
        }
    }
};

struct Args { const float* in[25]; float* out; unsigned char* ws; int ph_lo, ph_hi; };
enum { I_X = 0, I_C, I_CTX, I_CCTX, I_WMOD, I_BMOD, I_GMIX, I_GFFN, I_FAWIN, I_FAWOUT, I_SINK, I_RGWIN, I_RGCW, I_RGCB, I_RGWA, I_RGBA, I_RGWI, I_RGBI, I_RGLAM, I_RGWOUT, I_WUP, I_FCW, I_FCB, I_WDOWN, I_GFINAL };

__device__ __forceinline__ const float* inp(LAS unsigned char* lds, int i) {
    unsigned off = PTAB_OFF; asm volatile("" : "+s"(off));
    const volatile LAS unsigned* p = (const volatile LAS unsigned*)(lds + off) + 2 * i;
    const unsigned lo = __builtin_amdgcn_readfirstlane(p[0]), hi = __builtin_amdgcn_readfirstlane(p[1]);
    return (const float*)(GAS const float*)(((unsigned long long)hi << 32) | lo);
}
__device__ __forceinline__ unsigned char* opaque(unsigned char* p) { GAS unsigned char* q = (GAS unsigned char*)p; asm volatile("" : "+s"(q)); return (unsigned char*)q; }
struct TrItem { const float* W; bf16* WT; int ldw, k0, n0, Kdst, drow0, drow1; };
__device__ __forceinline__ void tr_load(const TrItem& d, float (&t)[64], int lane) {
    const float* Wp = d.W + (size_t)d.k0 * d.ldw + d.n0 + lane;
#pragma unroll
    for (int i = 0; i < 64; ++i) t[i] = __builtin_nontemporal_load(Wp + (size_t)i * d.ldw);
}
__device__ __forceinline__ void tr_store(const TrItem& d, const float (&t)[64], LAS unsigned* scr, int lane) {
#pragma unroll
    for (int i = 0; i < 32; ++i) scr[i * 65 + lane] = pk2(t[2 * i], t[2 * i + 1]);
    asm volatile("s_waitcnt lgkmcnt(0)" ::: "memory");
    const int c = lane & 7;
#pragma unroll
    for (int j = 0; j < 8; ++j) { const int n = (lane >> 3) + 8 * j; const LAS unsigned* sp = scr + (4 * c) * 65 + n;
        const v4u o = (v4u){sp[0], sp[65], sp[130], sp[195]};
        const int drow = n < 32 ? d.drow0 + n : d.drow1 + (n - 32);
        *(v4u*)(d.WT + (size_t)drow * d.Kdst + d.k0 + 8 * c) = o; }
    asm volatile("s_waitcnt lgkmcnt(0)" ::: "memory");
}

constexpr int BG0_PRO = 11;
constexpr int NI_FA = 32 * 36 + 32 * 32, NI_RG = 32 * 64 + 32 * 32 + 2 * 2 * 8 * 4 * 4, NI_UP = 32 * 176, NI_DN = 88 * 32, MODKS = 32, NI_MOD = 48 * MODKS;
__device__ __forceinline__ int layer_items(int L) { return ((L & 1) ? NI_RG : NI_FA) + NI_UP + NI_DN; }
__device__ __forceinline__ TrItem layer_item(unsigned char* ws, LAS unsigned char* lds, int L, int r) {
    const int l = L >> 1; TrItem d;
    if ((L & 1) == 0) {
        if (r < 32 * 36) { const int kb = r / 36, nb = r % 36; d = TrItem{inp(lds, I_FAWIN) + (size_t)l * D * FA_IN, (bf16*)(ws + WS_WINFA) + (size_t)l * FA_IN * D, FA_IN, kb * 64, nb * 64, D, nb * 64, nb * 64 + 32}; return d; } r -= 32 * 36;
        if (r < 32 * 32) { const int kb = r / 32, nb = r % 32; d = TrItem{inp(lds, I_FAWOUT) + (size_t)l * D * D, (bf16*)(ws + WS_WOUTFA) + (size_t)l * D * D, D, kb * 64, nb * 64, D, nb * 64, nb * 64 + 32}; return d; } r -= 32 * 32;
    } else {
        if (r < 32 * 64) { const int kb = r / 64, nb = r % 64; d = TrItem{inp(lds, I_RGWIN) + (size_t)l * D * 4096, (bf16*)(ws + WS_WINRG) + (size_t)l * 4096 * D, 4096, kb * 64, nb * 64, D, nb * 64, nb * 64 + 32}; return d; } r -= 32 * 64;
        if (r < 32 * 32) { const int kb = r / 32, nb = r % 32; d = TrItem{inp(lds, I_RGWOUT) + (size_t)l * D * D, (bf16*)(ws + WS_WOUTRG) + (size_t)l * D * D, D, kb * 64, nb * 64, D, nb * 64, nb * 64 + 32}; return d; } r -= 32 * 32;
        if (r < 512) {
            const int nb = r & 3, kb = (r >> 2) & 3, h = (r >> 4) & 7, dd = (r >> 7) & 1, ai = (r >> 8) & 1;
            const int n0 = nb * 64; const int drow = h * 1024 + (dd * 2 + (n0 >> 7)) * 256 + ai * 128 + (n0 & 127);
            d = TrItem{inp(lds, ai ? I_RGWI : I_RGWA) + ((size_t)((l * 2 + dd) * 8 + h)) * 256 * 256, (bf16*)(ws + WS_WGATE) + (size_t)l * 8 * 1024 * 256, 256, kb * 64, n0, 256, drow, drow + 32}; return d; } r -= 512;
    }
    if (r < NI_UP) { const int kb = r / 176, nb = r % 176;
        const int n0 = nb * 64, isv = n0 >= DFF, nn = isv ? n0 - DFF : n0;
        const int dr = (nn >> 7) * 256 + isv * 128 + (nn & 127);
        d = TrItem{inp(lds, I_WUP) + (size_t)L * D * DFF2, (bf16*)(ws + WS_WUP) + (size_t)L * DFF2 * D, DFF2, kb * 64, n0, D, dr, dr + 32}; return d; } r -= NI_UP;
    { const int kb = r / 32, nb = r % 32; d = TrItem{inp(lds, I_WDOWN) + (size_t)L * DFF * D, (bf16*)(ws + WS_WDOWN) + (size_t)L * D * DFF, D, kb * 64, nb * 64, DFF, nb * 64, nb * 64 + 32}; }
    return d;
}
__device__ __forceinline__ void run_layer_items(unsigned char* ws, LAS unsigned char* lds, int L, int it0, int stride, int tot, LAS unsigned* scr, int lane) {
    if (it0 >= tot) return;
    float ta[64], tb[64];
    TrItem da = layer_item(ws, lds, L, it0); tr_load(da, ta, lane);
    for (int it = it0; it < tot; it += stride) {
        const bool more = it + stride < tot; TrItem db = da;
        if (more) { db = layer_item(ws, lds, L, it + stride); tr_load(db, tb, lane); }
        tr_store(da, ta, scr, lane);
        if (more) { da = db;
#pragma unroll
            for (int i = 0; i < 64; ++i) ta[i] = tb[i]; }
    }
}
__device__ __forceinline__ void mod_item(unsigned char* ws, LAS unsigned char* lds, int L, int it, int lane) {
    constexpr int RK = D / MODKS;
    const int ks = it % MODKS, cg = it / MODKS;
    const float* W = inp(lds, I_WMOD) + (size_t)L * D * NMOD6 + (size_t)(ks * RK) * NMOD6 + cg * 256 + lane * 4;
    const float* cl = inp(lds, I_C) + ks * RK; const float* cc = inp(lds, I_CCTX) + ks * RK;
    f32x4 al = (f32x4){0.f, 0.f, 0.f, 0.f}, ac = al;
    for (int k = 0; k < RK; k += 16) {
        f32x4 w[16];
#pragma unroll
        for (int j = 0; j < 16; ++j) w[j] = __builtin_nontemporal_load((const f32x4*)(W + (size_t)(k + j) * NMOD6));
#pragma unroll
        for (int j = 0; j < 16; ++j) { const float s0 = siluf_(cl[k + j]), s1 = siluf_(cc[k + j]); al += w[j] * s0; ac += w[j] * s1; }
    }
    if (ks == 0) { const f32x4 b = *(const f32x4*)(inp(lds, I_BMOD) + (size_t)L * NMOD6 + cg * 256 + lane * 4); al += b; ac += b; }
    float* o = (float*)(ws + WS_MODP) + ((size_t)(ks * 4 + L) * 2) * NMOD6 + cg * 256 + lane * 4;
    *(f32x4*)o = al; *(f32x4*)(o + NMOD6) = ac;
}
__device__ __forceinline__ void mod_final(unsigned char* ws, int L, int bid, int G, int wv) {
    if (L >= DEPTH) return;
    const int tid = otid(wv); const int gtid = bid * NTHR + tid, NGT = G * NTHR;
    const float* part = (const float*)(ws + WS_MODP); float* mod = (float*)(ws + WS_MOD);
    for (int e = gtid; e < 2 * NMOD6; e += NGT) { const int ee = L * 2 * NMOD6 + e; float sacc = 0.f;
#pragma unroll
        for (int ks = 0; ks < MODKS; ++ks) sacc += part[(size_t)ks * 4 * 2 * NMOD6 + ee];
        mod[ee] = sacc; }
}
__device__ __forceinline__ void bg_run(unsigned char* ws, LAS unsigned char* lds, int tgt, int first_idle, int pctA, int pctB, int bid, int G, int wv) {
    if (tgt >= DEPTH) return;
    const int tid = otid(wv), lane = tid & 63;
    LAS unsigned* scr = (LAS unsigned*)(lds + wv * 8448);
    const int tot = layer_items(tgt), nA = (tot * pctA / 100);
    if (bid >= first_idle) {
        const int giw = (bid - first_idle) * NWAVES + wv, nw = (G - first_idle) * NWAVES;
        for (int it = giw; it < NI_MOD; it += nw) mod_item(ws, lds, tgt, it, lane);
        run_layer_items(ws, lds, tgt, (giw + nw - NI_MOD % nw) % nw, nw, nA, scr, lane);
    }
    run_layer_items(ws, lds, tgt, nA + bid * NWAVES + wv, G * NWAVES, tot * pctB / 100, scr, lane);
}
__device__ __forceinline__ void bg_part(unsigned char* ws, LAS unsigned char* lds, int tgt, int nunits, int p0, int p1, int bid, int G, int wv) {
    const int first_idle = nunits - ((nunits - 1) / G) * G;
    if (tgt >= DEPTH || bid < first_idle) return;
    const int tid = otid(wv), lane = tid & 63;
    LAS unsigned* scr = (LAS unsigned*)(lds + wv * 8448);
    const int tot = layer_items(tgt);
    run_layer_items(ws, lds, tgt, tot * p0 / 100 + (bid - first_idle) * NWAVES + wv, (G - first_idle) * NWAVES, tot * p1 / 100, scr, lane);
}

__device__ __forceinline__ void bg_slot(unsigned char* ws, LAS unsigned char* lds, int tgt, int idx, int nidle, bool withmod, int p0, int p1, int wv) {
    if (tgt >= DEPTH || idx < 0) return;
    const int tid = otid(wv), lane = tid & 63;
    LAS unsigned* scr = (LAS unsigned*)(lds + wv * 8448);
    const int giw = idx * NWAVES + wv, nw = nidle * NWAVES; int skew = 0;
    if (withmod) { for (int it = giw; it < NI_MOD; it += nw) mod_item(ws, lds, tgt, it, lane); skew = NI_MOD % nw; }
    const int tot = layer_items(tgt);
    run_layer_items(ws, lds, tgt, tot * p0 / 100 + (giw + nw - skew) % nw, nw, tot * p1 / 100, scr, lane);
}
__device__ __forceinline__ int tail_first(int nunits, int G) { return nunits - ((nunits - 1) / G) * G; }

__device__ __forceinline__ void phase_prologue(unsigned char* ws, LAS unsigned char* lds, int bid, int G, int wv) {
    const int tid = otid(wv), lane = tid & 63, wave = wv; const int gw = bid * NWAVES + wave, NGW = G * NWAVES, gtid = bid * NTHR + tid, NGT = G * NTHR; (void)lane; (void)gw; (void)NGW; (void)gtid; (void)NGT;
    LAS unsigned* scr = (LAS unsigned*)(lds + wave * 8448);
    for (int it = gw; it < NI_MOD; it += NGW) mod_item(ws, lds, 0, it, lane);
    run_layer_items(ws, lds, 0, (gw + NGW - NI_MOD % NGW) % NGW, NGW, layer_items(0) * BG0_PRO / 100, scr, lane);
    {
        bf16* DA = (bf16*)(ws + WS_DA);
        for (int e = gtid; e < 256 * 256; e += NGT) { const int r = e >> 8, cc = e & 255, c = r >> 7, k1 = r & 127, cp = cc >> 7, n1 = cc & 127; const int ph = (k1 * n1) & 127; float sv, cv; sincospif((float)ph * (1.0f / 64.0f), &sv, &cv);
            const float v = (c == 0) ? (cp == 0 ? cv : -sv) : (cp == 0 ? -sv : -cv); DA[e] = (bf16)f2bf(v); }
        bf16* DB = (bf16*)(ws + WS_DB4);
        for (int e = gtid; e < 256 * 512; e += NGT) { const int r = e >> 9, cc = e & 511, pp = r >> 6, k2 = r & 63, p = cc >> 7, c = (cc >> 6) & 1, n2 = cc & 63; const int ph = (k2 * n2) & 63; float sv, cv; sincospif((float)ph * (1.0f / 32.0f), &sv, &cv);
            DB[e] = (bf16)f2bf(p == pp ? (c ? sv : cv) : 0.0f); }
        float* twc = (float*)(ws + WS_TW); float* tws = twc + 128 * 64;
        for (int e = gtid; e < 128 * 64; e += NGT) { const int k1 = e >> 6, n2 = e & 63; float sv, cv; sincospif((float)(k1 * n2) * (1.0f / 4096.0f), &sv, &cv); twc[e] = cv; tws[e] = sv; }
        bf16* C = (bf16*)(ws + WS_DFTC);
        for (int e = gtid; e < 512 * 256; e += NGT) { const int mp = e >> 8, c = e & 255, m = mp >> 1, s = mp & 1; const int ph = (m * c) & 255; float sv, cv; sincospif((float)ph * (1.0f / 128.0f), &sv, &cv); C[e] = (bf16)f2bf(s ? sv : cv); }
        bf16* N = (bf16*)(ws + WS_DFTNC);
        for (int e = gtid; e < 256 * 512; e += NGT) { const int k = e >> 9, cc = e & 511, s = cc >> 8, n = cc & 255; const int ph = (k * n) & 255; float sv, cv; sincospif((float)ph * (1.0f / 128.0f), &sv, &cv); N[e] = (bf16)f2bf(s ? -sv : cv); }
        float* rc = (float*)(ws + WS_ROPE); float* rs = rc + 128 * 16;
        { const float* lam = inp(lds, I_RGLAM); float* sp8 = (float*)(ws + WS_SP8); for (int e = gtid; e < 2 * 2 * D; e += NGT) { const float z = -lam[e]; sp8[e] = -8.0f * (fmaxf(z, 0.f) + log1pf(expf(-fabsf(z)))); } }
        for (int e = gtid; e < 128 * 16; e += NGT) { const int pos = e >> 4, f = e & 15; const float inv = powf(10000.0f, -(float)f / 16.0f); const float ang = (float)pos * inv; rc[e] = cosf(ang); rs[e] = sinf(ang); }
    }
}
__device__ __forceinline__ void phase_norm(const float* XL32, const float* XC32, bf16* X, bf16* H, const float* g, const float* mod_lat, const float* mod_ctx, int ish, int isc, LAS unsigned char* lds, int nrows, const float* PART, int nsl, const float* gtc, int bid, int G, int wv) {
    const int tid = otid(wv), lane = tid & 63, wave = wv; const int gw = bid * NWAVES + wave, NGW = G * NWAVES;
    LAS float* T = (LAS float*)lds;
    for (int i = tid; i < D; i += NTHR) { const float gg = g[i];
        T[i] = gg * (1.0f + mod_lat[isc * D + i]); T[D + i] = mod_lat[ish * D + i]; T[2 * D + i] = gg * (1.0f + mod_ctx[isc * D + i]); T[3 * D + i] = mod_ctx[ish * D + i]; }
    __syncthreads();
    v2u nr[8]; bool have = false;
    if (gw < nrows && !(gw < SEQ ? XL32 != nullptr : XC32 != nullptr)) { const v2u* p = (const v2u*)(X + (size_t)gw * D) + lane;
#pragma unroll
        for (int j = 0; j < 8; ++j) nr[j] = p[64 * j];
        have = true; }
    for (int m = gw; m < nrows; m += NGW) {
        const float* src32 = m < SEQ ? (XL32 ? XL32 + (size_t)m * D : nullptr) : (XC32 ? XC32 + (size_t)(m - SEQ) * D : nullptr);
        v2u* xr = (v2u*)(X + (size_t)m * D) + lane;
        f32x4 v[8]; float s = 0.f;
        if (src32) {
#pragma unroll
            for (int j = 0; j < 8; ++j) v[j] = ((const f32x4*)src32 + lane)[64 * j];
        } else if (have) {
#pragma unroll
            for (int j = 0; j < 8; ++j) { const v2u w = nr[j]; v[j] = (f32x4){bflo(w.x), bfhi(w.x), bflo(w.y), bfhi(w.y)}; }
        } else {
#pragma unroll
            for (int j = 0; j < 8; ++j) { const v2u w = xr[64 * j]; v[j] = (f32x4){bflo(w.x), bfhi(w.x), bflo(w.y), bfhi(w.y)}; }
        }
        { const int mn = m + NGW; have = false;
          if (mn < nrows && !(mn < SEQ ? XL32 != nullptr : XC32 != nullptr)) { const v2u* p = (const v2u*)(X + (size_t)mn * D) + lane;
#pragma unroll
              for (int j = 0; j < 8; ++j) nr[j] = p[64 * j];
              have = true; } }
        if (m >= SEQ && nsl > 0) {
            f32x4 a[8];
#pragma unroll
            for (int j = 0; j < 8; ++j) a[j] = (f32x4){0.f, 0.f, 0.f, 0.f};
            for (int sl = 0; sl < nsl; ++sl) { const v2u* pr = (const v2u*)((const bf16*)PART + ((size_t)sl * 256 + (m - SEQ)) * D) + lane;
#pragma unroll
                for (int j = 0; j < 8; ++j) { const v2u w = pr[64 * j]; a[j] += (f32x4){bflo(w.x), bfhi(w.x), bflo(w.y), bfhi(w.y)}; } }
            const f32x4* g4 = (const f32x4*)gtc + lane;
#pragma unroll
            for (int j = 0; j < 8; ++j) { v[j] += g4[64 * j] * a[j]; v2u w; w.x = pk2(v[j][0], v[j][1]); w.y = pk2(v[j][2], v[j][3]); xr[64 * j] = w;
                v[j] = (f32x4){bflo(w.x), bfhi(w.x), bflo(w.y), bfhi(w.y)}; }
        }
#pragma unroll
        for (int j = 0; j < 8; ++j) s += (v[j][0] * v[j][0] + v[j][1] * v[j][1]) + (v[j][2] * v[j][2] + v[j][3] * v[j][3]);
        const float r = 1.0f / sqrtf(wave_sum(s, lane) * (1.0f / D) + EPS);
        const LAS f32x4* G4 = (const LAS f32x4*)(T + (m >= SEQ ? 2 * D : 0)) + lane; const LAS f32x4* S4 = (const LAS f32x4*)(T + (m >= SEQ ? 3 * D : D)) + lane;
        v2u* o = (v2u*)(H + (size_t)m * D) + lane;
#pragma unroll
        for (int j = 0; j < 8; ++j) { const f32x4 gg = G4[64 * j], ss = S4[64 * j]; const f32x4 h = (v[j] * r) * gg + ss; v2u w; w.x = pk2(h[0], h[1]); w.y = pk2(h[2], h[3]); o[64 * j] = w; }
    }
    __syncthreads();
}
__device__ __forceinline__ void phase_final(const bf16* X, float* out, const float* g, int bid, int G, int wv) {
    const int tid = otid(wv), lane = tid & 63, wave = wv; const int gw = bid * NWAVES + wave, NGW = G * NWAVES, gtid = bid * NTHR + tid, NGT = G * NTHR; (void)lane; (void)gw; (void)NGW; (void)gtid; (void)NGT;
    for (int m = gw; m < SEQ; m += NGW) {
        const v2u* xr = (const v2u*)(X + (size_t)m * D) + lane;
        f32x4 v[8]; float s = 0.f;
#pragma unroll
        for (int j = 0; j < 8; ++j) { const v2u w = xr[64 * j]; v[j] = (f32x4){bflo(w.x), bfhi(w.x), bflo(w.y), bfhi(w.y)}; s += (v[j][0] * v[j][0] + v[j][1] * v[j][1]) + (v[j][2] * v[j][2] + v[j][3] * v[j][3]); }
        const float r = 1.0f / sqrtf(wave_sum(s, lane) * (1.0f / D) + EPS);
        f32x4* o = (f32x4*)(out + (size_t)m * D) + lane; const f32x4* g4 = (const f32x4*)g + lane;
#pragma unroll
        for (int j = 0; j < 8; ++j) o[64 * j] = (v[j] * r) * g4[64 * j];
    }
}
__device__ __forceinline__ void phase_conv4(const bf16* XS, bf16* XSC, bf16* GATE, const float* PART2, const float* cw, const float* cb, int bid, int G, int wv) {
    const int tid = otid(wv), lane = tid & 63, wave = wv; const int gw = bid * NWAVES + wave, NGW = G * NWAVES, gtid = bid * NTHR + tid, NGT = G * NTHR; (void)lane; (void)gw; (void)NGW; (void)gtid; (void)NGT;
    const int cg = gtid & 255, r0 = gtid >> 8, rstep = NGT >> 8;
    float w[4][8], b[8];
#pragma unroll
    for (int i = 0; i < 8; ++i) { b[i] = cb[cg * 8 + i];
#pragma unroll
        for (int k = 0; k < 4; ++k) w[k][i] = cw[k * D + cg * 8 + i]; }
    for (int t = r0; t < MT; t += rstep) {
        const int lo = t < SEQ ? 0 : SEQ, hi = t < SEQ ? SEQ : MT;
        float y[8];
#pragma unroll
        for (int i = 0; i < 8; ++i) y[i] = b[i];
        if (t >= SEQ) {
#pragma unroll
            for (int k = 0; k < 4; ++k) { const int tt = t + k - 2; if (tt >= SEQ && tt < MT) { f32x4 a0 = (f32x4){0.f, 0.f, 0.f, 0.f}, a1 = a0;
#pragma unroll
                    for (int sl = 0; sl < 2; ++sl) { const float* p = PART2 + ((size_t)sl * 256 + (tt - SEQ)) * 4096 + D + cg * 8; a0 += *(const f32x4*)p; a1 += *(const f32x4*)(p + 4); }
#pragma unroll
                    for (int i = 0; i < 4; ++i) { y[i] += w[k][i] * a0[i]; y[4 + i] += w[k][4 + i] * a1[i]; } } }
            f32x4 g0 = (f32x4){0.f, 0.f, 0.f, 0.f}, g1 = g0;
#pragma unroll
            for (int sl = 0; sl < 2; ++sl) { const float* p = PART2 + ((size_t)sl * 256 + (t - SEQ)) * 4096 + cg * 8; g0 += *(const f32x4*)p; g1 += *(const f32x4*)(p + 4); }
            *(v4u*)(GATE + (size_t)t * D + cg * 8) = (v4u){pk2(g0[0], g0[1]), pk2(g0[2], g0[3]), pk2(g1[0], g1[1]), pk2(g1[2], g1[3])};
            *(v4u*)(XSC + (size_t)t * D + cg * 8) = (v4u){pk2(y[0], y[1]), pk2(y[2], y[3]), pk2(y[4], y[5]), pk2(y[6], y[7])};
            continue;
        }
#pragma unroll
        for (int k = 0; k < 4; ++k) { const int tt = t + k - 2; if (tt >= lo && tt < hi) { const v4u x = *(const v4u*)(XS + (size_t)tt * D + cg * 8);
                y[0] += w[k][0] * bflo(x.x); y[1] += w[k][1] * bfhi(x.x); y[2] += w[k][2] * bflo(x.y); y[3] += w[k][3] * bfhi(x.y);
                y[4] += w[k][4] * bflo(x.z); y[5] += w[k][5] * bfhi(x.z); y[6] += w[k][6] * bflo(x.w); y[7] += w[k][7] * bfhi(x.w); } }
        *(v4u*)(XSC + (size_t)t * D + cg * 8) = (v4u){pk2(y[0], y[1]), pk2(y[2], y[3]), pk2(y[4], y[5]), pk2(y[6], y[7])};
    }
}
__device__ __forceinline__ void phase_conv3_ctx(const bf16* U, bf16* ACT, const float* cw, const float* cb, int bid, int G, int wv) {
    const int tid = otid(wv); const int gtid = bid * NTHR + tid, NGT = G * NTHR;
    constexpr int NCG = DFF / 8;
    for (int it = gtid; it < CTXL * NCG; it += NGT) {
        const int cg = it % NCG, t = SEQ + it / NCG, c0 = cg * 8, uc = (c0 >> 7) * 256 + (c0 & 127);
        float yg[8], yv[8];
#pragma unroll
        for (int i = 0; i < 8; ++i) { yg[i] = cb[c0 + i]; yv[i] = cb[DFF + c0 + i]; }
#pragma unroll
        for (int k = 0; k < 3; ++k) { const int tt = t + k - 1; if (tt >= SEQ && tt < MT) {
                const v4u x = *(const v4u*)(U + (size_t)tt * DFF2 + uc); const v4u z = *(const v4u*)(U + (size_t)tt * DFF2 + uc + 128);
                const float xg[8] = {bflo(x.x), bfhi(x.x), bflo(x.y), bfhi(x.y), bflo(x.z), bfhi(x.z), bflo(x.w), bfhi(x.w)}, xv[8] = {bflo(z.x), bfhi(z.x), bflo(z.y), bfhi(z.y), bflo(z.z), bfhi(z.z), bflo(z.w), bfhi(z.w)};
#pragma unroll
                for (int i = 0; i < 8; ++i) { yg[i] += cw[k * DFF2 + c0 + i] * xg[i]; yv[i] += cw[k * DFF2 + DFF + c0 + i] * xv[i]; } } }
        float o[8];
#pragma unroll
        for (int i = 0; i < 8; ++i) o[i] = siluf_(yg[i]) * yv[i];
        *(v4u*)(ACT + (size_t)t * DFF + c0) = (v4u){pk2(o[0], o[1]), pk2(o[2], o[3]), pk2(o[4], o[5]), pk2(o[6], o[7])};
    }
}
constexpr int NSEG = MT / 64;
template <int ST, int NSTEP> __device__ __forceinline__ void scan_col_sum(const LAS unsigned* T, float& h, float& ap) {
#pragma unroll
    for (int j0 = 0; j0 < NSTEP; j0 += 16) { unsigned w[16];
#pragma unroll
        for (int k = 0; k < 16; ++k) w[k] = (j0 + k < NSTEP) ? T[(j0 + k) * ST] : 0u;
#pragma unroll
        for (int k = 0; k < 16; ++k) if (j0 + k < NSTEP) { const float a = 1.0f - bflo(w[k]); h = a * h + bfhi(w[k]); ap *= a; } }
}
template <int ST> __device__ __forceinline__ void scan_col_apply(LAS unsigned* T, float h) {
#pragma unroll
    for (int j0 = 0; j0 < 64; j0 += 16) { unsigned w[16];
#pragma unroll
        for (int k = 0; k < 16; ++k) w[k] = T[(j0 + k) * ST];
#pragma unroll
        for (int k = 0; k < 16; ++k) { h = (1.0f - bflo(w[k])) * h + bfhi(w[k]); w[k] = __builtin_bit_cast(unsigned, h); }
#pragma unroll
        for (int k = 0; k < 16; ++k) T[(j0 + k) * ST] = w[k]; }
}
__device__ __forceinline__ void scan_fetch(v4u (&rg)[8], const unsigned* LG, int item, int tid) {
    const int row0 = (item >> 4) * 64, col0 = (item & 15) * 128;
#pragma unroll
    for (int i = 0; i < 8; ++i) { const int p = tid + i * NTHR, d = p >> 11, r = (p >> 5) & 63, c4 = p & 31; rg[i] = *(const v4u*)(LG + ((size_t)d * MT + row0 + r) * D + col0 + c4 * 4); }
}
__device__ __forceinline__ void scan_stash(LAS unsigned char* lds, const v4u (&rg)[8], int tid) {
#pragma unroll
    for (int i = 0; i < 8; ++i) *(LAS v4u*)(lds + (size_t)(tid + i * NTHR) * 16) = rg[i];
}
template <int NSTEP = 64, bool LOADS = true> __device__ __forceinline__ void phase_scan_sum(LAS unsigned char* lds, const unsigned* LG, float* SUM, int bid, int G, int wv) {
    const int tid = otid(wv);
    v4u rg[8];
    if (LOADS) { if (bid < NSEG * 16) scan_fetch(rg, LG, bid, tid); } else {
#pragma unroll
        for (int i = 0; i < 8; ++i) rg[i] = (v4u){0u, 0u, 0u, 0u}; }
    for (int item = bid; item < NSEG * 16; item += G) {
        const int seg = item >> 4, cg = item & 15;
        scan_stash(lds, rg, tid);
        __syncthreads();
        if (LOADS && item + G < NSEG * 16) scan_fetch(rg, LG, item + G, tid);
        if (tid < 256) { const int d = wv >> 1, col = tid & 127; const LAS unsigned* T = (const LAS unsigned*)lds + col;
            float h = 0.f, ap = 1.f;
            if (d == 0) scan_col_sum<128, NSTEP>(T, h, ap); else scan_col_sum<-128, NSTEP>(T + 8192 + 63 * 128, h, ap);
            float* o = SUM + ((size_t)(d * NSEG + seg) * D + cg * 128 + col) * 2; o[0] = ap; o[1] = h; }
        __syncthreads();
    }
}
__device__ __forceinline__ void phase_scan_carry(const float* SUM, float* HIN, int bid, int G, int wv) {
    const int tid = otid(wv); const int gtid = bid * NTHR + tid, NGT = G * NTHR;
    typedef float f32x2v __attribute__((ext_vector_type(2)));
    for (int it = gtid; it < 2 * D; it += NGT) { const int d = it >> 11, col = it & (D - 1);
        float h = 0.f;
        for (int s0 = 0; s0 < NSEG; s0 += 12) { f32x2v ab[12]; int sg[12];
#pragma unroll
            for (int j = 0; j < 12; ++j) { const int k = s0 + j;
                sg[j] = d == 0 ? (k < 4 ? 128 + k : k - 4) : (k < 4 ? 131 - k : 131 - k);
                ab[j] = *(const f32x2v*)(SUM + ((size_t)(d * NSEG + sg[j]) * D + col) * 2); }
#pragma unroll
            for (int j = 0; j < 12; ++j) { HIN[(size_t)(d * NSEG + sg[j]) * D + col] = h; h = ab[j].x * h + ab[j].y; } }
    }
}
__device__ __forceinline__ void phase_scan_apply(LAS unsigned char* lds, const unsigned* LG, const float* HIN, const bf16* GATE, bf16* Y, int bid, int G, int wv) {
    const int tid = otid(wv);
    v4u rg[8], gtn[2];
    if (bid < NSEG * 16) { scan_fetch(rg, LG, bid, tid);
#pragma unroll
        for (int i = 0; i < 2; ++i) { const int p = tid + i * NTHR, r = p >> 4, c8 = p & 15; gtn[i] = *(const v4u*)(GATE + (size_t)((bid >> 4) * 64 + r) * D + (bid & 15) * 128 + c8 * 8); } }
    for (int item = bid; item < NSEG * 16; item += G) {
        const int seg = item >> 4, cg = item & 15, row0 = seg * 64, col0 = cg * 128;
        scan_stash(lds, rg, tid);
        const v4u gt0 = gtn[0], gt1 = gtn[1];
        __syncthreads();
        if (item + G < NSEG * 16) { const int nx = item + G; scan_fetch(rg, LG, nx, tid);
#pragma unroll
            for (int i = 0; i < 2; ++i) { const int p = tid + i * NTHR, r = p >> 4, c8 = p & 15; gtn[i] = *(const v4u*)(GATE + (size_t)((nx >> 4) * 64 + r) * D + (nx & 15) * 128 + c8 * 8); } }
        if (tid < 256) { const int d = wv >> 1, col = tid & 127; LAS unsigned* T = (LAS unsigned*)lds + col;
            const float h = HIN[(size_t)(d * NSEG + seg) * D + col0 + col];
            if (d == 0) scan_col_apply<128>(T, h); else scan_col_apply<-128>(T + 8192 + 63 * 128, h); }
        __syncthreads();
#pragma unroll
        for (int i = 0; i < 2; ++i) { const int p = tid + i * NTHR, r = p >> 4, c8 = p & 15;
            const LAS f32x4* hf = (const LAS f32x4*)(lds + (size_t)(r * 128 + c8 * 8) * 4); const LAS f32x4* hb = (const LAS f32x4*)(lds + 32768 + (size_t)(r * 128 + c8 * 8) * 4);
            const f32x4 a0 = hf[0] + hb[0], a1 = hf[1] + hb[1]; const v4u g = i == 0 ? gt0 : gt1;
            v4u o; o.x = pk2(a0[0] * gelu_tanh(bflo(g.x)), a0[1] * gelu_tanh(bfhi(g.x))); o.y = pk2(a0[2] * gelu_tanh(bflo(g.y)), a0[3] * gelu_tanh(bfhi(g.y)));
            o.z = pk2(a1[0] * gelu_tanh(bflo(g.z)), a1[1] * gelu_tanh(bfhi(g.z))); o.w = pk2(a1[2] * gelu_tanh(bflo(g.w)), a1[3] * gelu_tanh(bfhi(g.w)));
            *(v4u*)(Y + (size_t)(row0 + r) * D + col0 + c8 * 8) = o; }
        __syncthreads();
    }
}
template <int MODE> __device__ __forceinline__ void phase_attn(LAS unsigned char* lds, const bf16* Q, const bf16* KB, const bf16* VB, bf16* Z, const float* sink, int bid, int G, int wv) {
    constexpr int KRS = 144, BUFB = 64 * KRS;
    const int tid = otid(wv), lane = tid & 63, wid = wv, r32 = lane & 31, hi = lane >> 5;
    LAS unsigned char* Kl = lds; LAS unsigned char* Vl = lds + 2 * BUFB;
    const int skey = tid >> 3, spiece = tid & 7;
    const int nun = (G == 256) ? 1 : (MODE == 0 ? (264 + G - 1) / G : 0);
    for (int ui = 0; ui < nun; ++ui) {
        int unit = bid + ui * G;
        if (G == 256 && MODE == 1) unit = (bid >= 132 && bid < 140) ? 256 + bid - 132 : 264;
        if (unit >= 264) continue;
        const bool isctx = unit >= 256; const int g = unit & 1; const int qb = isctx ? 128 + ((unit - 256) >> 1) : (unit >> 1);
        const int q0 = qb * 64, head = g * 8 + wid; const unsigned soff = (unsigned)(skey * 128 + g * 64 + spiece * 8);
        int c_lo = 0, nwin = 0;
        if (!isctx) { c_lo = qb < 2 ? 2 - qb : 0; const int c_hi = (130 - qb) < 5 ? (130 - qb) : 5; nwin = c_hi - c_lo; }
        const int nch = nwin + 4;
        bf16x8 qf[2][4];
#pragma unroll
        for (int qt = 0; qt < 2; ++qt)
#pragma unroll
            for (int s = 0; s < 4; ++s) qf[qt][s] = *(const bf16x8*)(Q + (size_t)(q0 + qt * 32 + r32) * 1024 + head * 64 + s * 16 + hi * 8);
        float mrun[2] = {-1e20f, -1e20f}, lrun[2] = {0.f, 0.f};
        f32x16 o[2][2];
#pragma unroll
        for (int a = 0; a < 2; ++a)
#pragma unroll
            for (int b = 0; b < 2; ++b)
#pragma unroll
                for (int r = 0; r < 16; ++r) o[a][b][r] = 0.f;
        v4u kvn, vvn;
        {
            const int kr = (0 < nwin) ? q0 - 128 + 64 * c_lo : SEQ;
            const v4u kv = *(const v4u*)(KB + (size_t)__builtin_amdgcn_readfirstlane(kr) * 128 + soff); const v4u vv = *(const v4u*)(VB + (size_t)__builtin_amdgcn_readfirstlane(kr) * 128 + soff);
            const int kr1 = (1 < nwin) ? q0 - 128 + 64 * (c_lo + 1) : SEQ + 64 * (1 - nwin);
            kvn = *(const v4u*)(KB + (size_t)__builtin_amdgcn_readfirstlane(kr1) * 128 + soff); vvn = *(const v4u*)(VB + (size_t)__builtin_amdgcn_readfirstlane(kr1) * 128 + soff);
            *(LAS v4u*)(Kl + skey * KRS + spiece * 16) = kv; *(LAS v4u*)(Vl + skey * KRS + spiece * 16) = vv;
        }
        __syncthreads();
        for (int ci = 0; ci < nch; ++ci) {
            const int buf = ci & 1;
            v4u kv2 = kvn, vv2 = vvn; const bool more = ci + 1 < nch;
            if (ci + 2 < nch) { const int cn = ci + 2; const int kr = (cn < nwin) ? q0 - 128 + 64 * (c_lo + cn) : SEQ + 64 * (cn - nwin);
                kv2 = *(const v4u*)(KB + (size_t)__builtin_amdgcn_readfirstlane(kr) * 128 + soff); vv2 = *(const v4u*)(VB + (size_t)__builtin_amdgcn_readfirstlane(kr) * 128 + soff); }
            const int cw_ = c_lo + ci;
            const bool masked = ci < nwin && (cw_ == 0 || cw_ == 4); const int krow = q0 - 128 + 64 * cw_;
            const LAS unsigned char* Kc = Kl + buf * BUFB; const LAS unsigned char* Vc = Vl + buf * BUFB;
            bf16x8 kf[2][4];
#pragma unroll
            for (int kt = 0; kt < 2; ++kt)
#pragma unroll
                for (int s = 0; s < 4; ++s) kf[kt][s] = *(const LAS bf16x8*)(Kc + (kt * 32 + r32) * KRS + (s * 16 + hi * 8) * 2);
            bf16x8 pf[2][2][2];
#pragma unroll
            for (int qt = 0; qt < 2; ++qt) {
                f32x16 st[2];
#pragma unroll
                for (int kt = 0; kt < 2; ++kt) {
#pragma unroll
                    for (int r = 0; r < 16; ++r) st[kt][r] = 0.f;
#pragma unroll
                    for (int s = 0; s < 4; ++s) st[kt] = __builtin_amdgcn_mfma_f32_32x32x16_bf16(kf[kt][s], qf[qt][s], st[kt], 0, 0, 0); }
                if (masked) {
                    int r32m = r32, him = hi; asm volatile("" : "+v"(r32m), "+v"(him));
                    const int qp = q0 + qt * 32 + r32m;
#pragma unroll
                    for (int kt = 0; kt < 2; ++kt)
#pragma unroll
                        for (int r = 0; r < 16; ++r) { const int dd = krow + kt * 32 + (r & 3) + 8 * (r >> 2) + 4 * him - qp; if (dd > 128 || dd < -128) st[kt][r] = -1e30f; } }
                float mx = fmaxf(st[0][0], st[1][0]);
#pragma unroll
                for (int r = 1; r < 16; ++r) mx = fmaxf(mx, fmaxf(st[0][r], st[1][r]));
                mx = fmaxf(mx, lane_xor(mx, lane, 32));
                if (__builtin_amdgcn_ballot_w64(mx > mrun[qt]) != 0ull) {
                    const float mn = fmaxf(mrun[qt], mx), alpha = exp2f(mrun[qt] - mn); mrun[qt] = mn; lrun[qt] *= alpha;
#pragma unroll
                    for (int dt = 0; dt < 2; ++dt)
#pragma unroll
                        for (int r = 0; r < 16; ++r) o[dt][qt][r] *= alpha; }
                const float mref = mrun[qt]; float ls4[4] = {0.f, 0.f, 0.f, 0.f};
#pragma unroll
                for (int kt = 0; kt < 2; ++kt) {
#pragma unroll
                    for (int r = 0; r < 16; ++r) { const float p = __builtin_amdgcn_exp2f(st[kt][r] - mref); st[kt][r] = p; ls4[r & 3] += p; }
#pragma unroll
                    for (int s2 = 0; s2 < 2; ++s2) { v4u w; w.x = pg8::cvt_pk_bf16(st[kt][8 * s2 + 0], st[kt][8 * s2 + 1]); w.y = pg8::cvt_pk_bf16(st[kt][8 * s2 + 2], st[kt][8 * s2 + 3]);
                        w.z = pg8::cvt_pk_bf16(st[kt][8 * s2 + 4], st[kt][8 * s2 + 5]); w.w = pg8::cvt_pk_bf16(st[kt][8 * s2 + 6], st[kt][8 * s2 + 7]); pf[qt][kt][s2] = __builtin_bit_cast(bf16x8, w); } }
                lrun[qt] += (ls4[0] + ls4[1]) + (ls4[2] + ls4[3]);
            }
            {
                const int i16 = lane & 15, qq = i16 >> 2, pp = i16 & 3;
                const LAS unsigned char* vb = Vc + (4 * hi + qq) * KRS + (16 * ((lane >> 4) & 1) + 4 * pp) * 2;
#pragma unroll
                for (int kt = 0; kt < 2; ++kt) {
                    s16x4 vlo[2][2], vhi[2][2];
#pragma unroll
                    for (int dt = 0; dt < 2; ++dt)
#pragma unroll
                        for (int s2 = 0; s2 < 2; ++s2) { const LAS unsigned char* va = vb + (kt * 32 + 16 * s2) * KRS + dt * 64;
                            vlo[dt][s2] = __builtin_bit_cast(s16x4, __builtin_amdgcn_ds_read_tr16_b64_v4i16((LAS s16x4*)va));
                            vhi[dt][s2] = __builtin_bit_cast(s16x4, __builtin_amdgcn_ds_read_tr16_b64_v4i16((LAS s16x4*)(va + 8 * KRS))); }
#pragma unroll
                    for (int s2 = 0; s2 < 2; ++s2)
#pragma unroll
                        for (int dt = 0; dt < 2; ++dt) { const s16x4 lo = vlo[dt][s2], hi4 = vhi[dt][s2];
                            const bf16x8 vf = (bf16x8){lo[0], lo[1], lo[2], lo[3], hi4[0], hi4[1], hi4[2], hi4[3]};
#pragma unroll
                            for (int qt = 0; qt < 2; ++qt) o[dt][qt] = __builtin_amdgcn_mfma_f32_32x32x16_bf16(vf, pf[qt][kt][s2], o[dt][qt], 0, 0, 0); }
                }
            }
            if (more) { const int nb = buf ^ 1; *(LAS v4u*)(Kl + nb * BUFB + skey * KRS + spiece * 16) = kvn; *(LAS v4u*)(Vl + nb * BUFB + skey * KRS + spiece * 16) = vvn; }
            kvn = kv2; vvn = vv2;
            __syncthreads();
        }
        const float sk = sink[head] * LOG2E;
        int r32z = r32, hiz = hi; asm volatile("" : "+v"(r32z), "+v"(hiz));
#pragma unroll
        for (int qt = 0; qt < 2; ++qt) {
            const float mn = fmaxf(mrun[qt], sk), alpha = exp2f(mrun[qt] - mn);
            float l = lrun[qt]; l += lane_xor(l, lane, 32); l = l * alpha + exp2f(sk - mn);
            const float inv = alpha / l;
            bf16* zr = Z + (size_t)(q0 + qt * 32 + r32z) * D + 1024 + head * 64;
#pragma unroll
            for (int dt = 0; dt < 2; ++dt)
#pragma unroll
                for (int r4 = 0; r4 < 4; ++r4) { v2u w; w.x = pk2(o[dt][qt][4 * r4 + 0] * inv, o[dt][qt][4 * r4 + 1] * inv); w.y = pk2(o[dt][qt][4 * r4 + 2] * inv, o[dt][qt][4 * r4 + 3] * inv);
                    *(v2u*)(zr + dt * 32 + 8 * r4 + 4 * hiz) = w; }
        }
    }
}

constexpr int PH_FINAL = 2 + 16 * DEPTH, PH_END = PH_FINAL + 1;
__global__ void __launch_bounds__(NTHR, 2) fwd_kernel(Args a) {
    extern __shared__ __attribute__((aligned(16))) unsigned char lds_raw[];
    LAS unsigned char* lds = (LAS unsigned char*)lds_raw;
    volatile LAS unsigned* MISC = (volatile LAS unsigned*)(lds + MISC_OFF);
    const int tid = threadIdx.x; const int wv = __builtin_amdgcn_readfirstlane(tid >> 6);
    for (int u = tid; u < (LDS_BYTES - RING_BYTES) / 4; u += NTHR) ((LAS unsigned*)(lds + RING_BYTES))[u] = 0u;
    __syncthreads();
    if (tid < 25) ((LAS unsigned long long*)(lds + PTAB_OFF))[tid] = (unsigned long long)a.in[tid];
    __syncthreads();
    const int lo = a.ph_lo, hi = a.ph_hi;
    XcdBarrier bar; bar.bar = (unsigned*)(a.ws + WS_CTL) + CW_BAR; bar.x = 0; bar.st = nullptr;
    if (hi - lo > 1) bar = xcd_barrier_post((unsigned*)(a.ws + WS_CTL) + CW_BAR, MISC + 8);
#define IN(k) in_range(lo, hi, (k))
#define SEAM(k) do { if (IN(k) && IN((k) + 1)) xcd_barrier(bar, wv); } while (0)
#define BG(frac_num) do { } while (0)
#define WSP unsigned char* ws = opaque(a.ws); const int bid = obid(), G = ogrid(); (void)bid; (void)G

    if (IN(0)) { WSP; phase_prologue(ws, lds, bid, G, wv); __syncthreads(); if (PROBE == 4) { phase_prologue(ws, lds, bid, G, wv); __syncthreads(); } } SEAM(0);
    if (IN(1)) { WSP; mod_final(ws, 0, bid, G, wv); } SEAM(1);

#pragma unroll 1
    for (int L = 0; L < DEPTH; ++L) {
        const int pb = 2 + 16 * L, li = L >> 1;
#define MODL ((const float*)(ws + WS_MOD) + (size_t)(L * 2 + 0) * NMOD6)
#define MODC ((const float*)(ws + WS_MOD) + (size_t)(L * 2 + 1) * NMOD6)
        const bool ctx_out = L < DEPTH - 1;
        if (PROBE == 20 && hi - lo > 1) { for (int rep = 0; rep < 8; ++rep) xcd_barrier(bar, wv); }
        if (IN(pb + 0)) { WSP;
            phase_norm(L == 0 ? inp(lds, I_X) : (const float*)nullptr, L == 0 ? inp(lds, I_CTX) : (const float*)nullptr, (bf16*)(ws + WS_X), (bf16*)(ws + WS_H), inp(lds, I_GMIX) + L * D, MODL, MODC, 0, 1, lds, MT, (const float*)(ws + WS_PART), L > 0 ? 4 : 0, (const float*)(ws + WS_MOD) + (size_t)((L > 0 ? L - 1 : 0) * 2 + 1) * NMOD6 + 5 * D, bid, G, wv); }
        SEAM(pb + 0);
        if ((L & 1) == 0) {
            if (IN(pb + 1)) { WSP;
                pg8::Gemm g = pg8::mk_gemm((const bf16*)(ws + WS_H), (const bf16*)(ws + WS_WINFA) + (size_t)li * FA_IN * D, D, D, D, 0, 0); pg8::Order S; S.init(33, 9, 1, G, bid, g.K);
                EpiRope E{(bf16*)(ws + WS_F), (bf16*)(ws + WS_Q), (bf16*)(ws + WS_KB), (bf16*)(ws + WS_VB), (const float*)(ws + WS_ROPE), (const float*)(ws + WS_ROPE) + 128 * 16};
                pg8::gemm_phase<EpiRope, true>(lds, g, S, E, wv);
                if (PROBE == 6) { __syncthreads(); pg8::gemm_phase<EpiRope, true>(lds, g, S, E, wv); }
                { const int fi = tail_first(297, G); bg_slot(ws, lds, L + 1, bid - fi, G - fi, true, 0, 30, wv); }
            }
            SEAM(pb + 1);
            if (IN(pb + 2)) {
                {   WSP;
                    pg8::Gemm g = pg8::mk_gemm((const bf16*)(ws + WS_DFTC), (const bf16*)(ws + WS_F), 256, 1024, 256, 0, 256); g.rmB = 64; g.hsB = 1024 * 2; g.tsB = 2 * 1024 * 2;
                    pg8::Order S; S.init(2, 32, 4, G, bid, g.K);
                    EpiX3 E{(bf16*)(ws + WS_VT)};
                    pg8::gemm_phase<EpiX3, true>(lds, g, S, E, wv);
                    if (PROBE == 12) { __syncthreads(); pg8::gemm_phase<EpiX3, true>(lds, g, S, E, wv); }
                }
                {   WSP;
                    pg8::Gemm g = pg8::mk_gemm((const bf16*)(ws + WS_DFTC), (const bf16*)(ws + WS_F) + (size_t)SEQ * 1024, 256, 1024, 256, 0, 256); pg8::Order S; S.init(2, 1, 4, G, (bid + G - 16) % G, g.K);
                    EpiStore E{(bf16*)(ws + WS_VTC), 256, (long)512 * 256, 0, 0, 1.0f};
                    pg8::gemm_phase<EpiStore, true>(lds, g, S, E, wv);
                }
                __syncthreads();
                {   WSP;
                    phase_attn<0>(lds, (const bf16*)(ws + WS_Q), (const bf16*)(ws + WS_KB), (const bf16*)(ws + WS_VB), (bf16*)(ws + WS_Z), inp(lds, I_SINK) + li * 16, bid, G, wv);
                    __syncthreads();
                    { const int idx = G == 256 ? (bid < 16 ? bid : (bid >= 24 ? bid - 8 : -1)) : bid, nidle = G == 256 ? 248 : G;
                      bg_slot(ws, lds, L == 0 ? 0 : 3, idx, nidle, false, L == 0 ? BG0_PRO : 30, L == 0 ? 30 : 42, wv); }
                }
            }
            SEAM(pb + 2);
            if (IN(pb + 3)) {
                {   WSP;
                    pg8::Gemm g = pg8::mk_gemm((const bf16*)(ws + WS_DA), (const bf16*)(ws + WS_VT), 256, 256, 256, 0, 0); pg8::Order S; S.init(1, 256, 1, G, bid, g.K);
                    EpiTw E{(bf16*)(ws + WS_ZP), (const float*)(ws + WS_TW), (const float*)(ws + WS_TW) + 128 * 64};
                    pg8::gemm_phase<EpiTw, true>(lds, g, S, E, wv);
                    if (PROBE == 10) { __syncthreads(); pg8::gemm_phase<EpiTw, true>(lds, g, S, E, wv); }
                }
            }
            SEAM(pb + 3);
            if (IN(pb + 4)) { WSP;
                pg8::Gemm g = pg8::mk_gemm((const bf16*)(ws + WS_DB4), (const bf16*)(ws + WS_ZP), 512, 16384, 512, 0, 512); pg8::Order S; S.init(1, 4, 32, G, bid, g.K);
                EpiFftOut E{(bf16*)(ws + WS_Z), 1.0f / 1448.1546878700494f};
                pg8::gemm_phase<EpiFftOut, true>(lds, g, S, E, wv);
                {
                    pg8::Gemm g2 = pg8::mk_gemm((const bf16*)(ws + WS_DFTNC), (const bf16*)(ws + WS_VTC), 512, 512, 512, 0, 0); pg8::Order S2; S2.init(1, 4, 1, G, G >= 256 ? (bid + G - 128) % G : bid, g2.K);
                    EpiStore E2{(bf16*)(ws + WS_Z) + (size_t)SEQ * D, D, 0, 0, 0, 1.0f / 256.0f};
                    pg8::gemm_phase<EpiStore, true>(lds, g2, S2, E2, wv);
                }
                __syncthreads();
                phase_attn<1>(lds, (const bf16*)(ws + WS_Q), (const bf16*)(ws + WS_KB), (const bf16*)(ws + WS_VB), (bf16*)(ws + WS_Z), inp(lds, I_SINK) + li * 16, bid, G, wv);
                __syncthreads();
                { const int fi = tail_first(128, G); bg_slot(ws, lds, L == 0 ? 0 : 3, bid - fi, G - fi, false, L == 0 ? 30 : 42, L == 0 ? 66 : 65, wv); }
            }
            SEAM(pb + 4);
            if (IN(pb + 5)) { WSP;
                pg8::Gemm g = pg8::mk_gemm((const bf16*)(ws + WS_Z), (const bf16*)(ws + WS_WOUTFA) + (size_t)li * D * D, D, D, D, 0, 0); pg8::OrderSplit S; S.init(32, 8, 1, G, bid, g.K); S.extra(4, 32, 8, 512);
                EpiResid E{(bf16*)(ws + WS_X), MODL + 2 * D, MODC + 2 * D, (float*)(ws + WS_PART), L == 0 ? inp(lds, I_X) : (const float*)nullptr, (const bf16*)(ws + WS_X)};
                pg8::gemm_phase<EpiResid, true>(lds, g, S, E, wv);
                { const int fi = tail_first(256 + 32, G); bg_slot(ws, lds, L == 0 ? 0 : 3, bid - fi, G - fi, false, L == 0 ? 66 : 65, L == 0 ? 78 : 73, wv); }
            }
            SEAM(pb + 5);
        } else {
            if (IN(pb + 1)) { WSP;
                pg8::Gemm g = pg8::mk_gemm((const bf16*)(ws + WS_H), (const bf16*)(ws + WS_WINRG) + (size_t)li * 4096 * D, D, D, D, 0, 0); pg8::OrderSplit S; S.init(32, 16, 1, G, bid, g.K); S.extra(2, 32, 16, 1024);
                EpiRgIn E{(bf16*)(ws + WS_GATE), (bf16*)(ws + WS_XS), (float*)(ws + WS_PART2)};
                pg8::gemm_phase<EpiRgIn, true>(lds, g, S, E, wv);
                if (PROBE == 15) { __syncthreads(); pg8::gemm_phase<EpiRgIn, true>(lds, g, S, E, wv); }
                if (L == 1) { const int fi = tail_first(512 + 32, G); bg_slot(ws, lds, 2, bid - fi, G - fi, true, 0, 5, wv); }
            }
            SEAM(pb + 1);
            if (IN(pb + 2)) { WSP; phase_conv4((const bf16*)(ws + WS_XS), (bf16*)(ws + WS_XSC), (bf16*)(ws + WS_GATE), (const float*)(ws + WS_PART2), inp(lds, I_RGCW) + (size_t)li * 4 * D, inp(lds, I_RGCB) + (size_t)li * D, bid, G, wv); }
            SEAM(pb + 2);
            if (IN(pb + 3)) { WSP;
                pg8::Gemm g = pg8::mk_gemm((const bf16*)(ws + WS_XSC), (const bf16*)(ws + WS_WGATE) + (size_t)li * 8 * 1024 * 256, D, 256, 256, 256, (long)1024 * 256); pg8::Order S; S.init(33, 4, 8, G, bid, g.K);
                EpiGates E{inp(lds, I_RGBA) + (size_t)li * 2 * D, inp(lds, I_RGBI) + (size_t)li * 2 * D, (const float*)(ws + WS_SP8) + (size_t)li * 2 * D, (const bf16*)(ws + WS_XSC), (unsigned*)(ws + WS_LG)};
                pg8::gemm_phase<EpiGates, true>(lds, g, S, E, wv);
                if (PROBE == 7) { __syncthreads(); pg8::gemm_phase<EpiGates, true>(lds, g, S, E, wv); }
                if (L == 1) { const int fi = tail_first(33 * 4 * 8, G); bg_slot(ws, lds, 2, bid - fi, G - fi, false, 5, 25, wv); }
            }
            SEAM(pb + 3);
            if (IN(pb + 4)) { WSP; phase_scan_sum(lds, (const unsigned*)(ws + WS_LG), (float*)(ws + WS_SCAN), bid, G, wv); if (PROBE == 8) phase_scan_sum(lds, (const unsigned*)(ws + WS_LG), (float*)(ws + WS_SCAN), bid, G, wv);
                if (PROBE == 13) phase_scan_sum<1, true>(lds, (const unsigned*)(ws + WS_LG), (float*)(ws + WS_HF), bid, G, wv);
                if (PROBE == 14) phase_scan_sum<64, false>(lds, (const unsigned*)(ws + WS_LG), (float*)(ws + WS_HF), bid, G, wv); }
            SEAM(pb + 4);
            if (IN(pb + 5)) { WSP; phase_scan_carry((const float*)(ws + WS_SCAN), (float*)(ws + WS_SCAN + 5 * MiB), bid, G, wv); }
            SEAM(pb + 5);
            if (IN(pb + 6)) { WSP; phase_scan_apply(lds, (const unsigned*)(ws + WS_LG), (const float*)(ws + WS_SCAN + 5 * MiB), (const bf16*)(ws + WS_GATE), (bf16*)(ws + WS_Z), bid, G, wv); if (PROBE == 9) phase_scan_apply(lds, (const unsigned*)(ws + WS_LG), (const float*)(ws + WS_SCAN + 5 * MiB), (const bf16*)(ws + WS_GATE), (bf16*)(ws + WS_Z), bid, G, wv); }
            SEAM(pb + 6);
            if (IN(pb + 7)) { WSP;
                pg8::Gemm g = pg8::mk_gemm((const bf16*)(ws + WS_Z), (const bf16*)(ws + WS_WOUTRG) + (size_t)li * D * D, D, D, D, 0, 0); pg8::OrderSplit S; S.init(32, 8, 1, G, bid, g.K); if (ctx_out) S.extra(4, 32, 8, 512);
                EpiResid E{(bf16*)(ws + WS_X), MODL + 2 * D, MODC + 2 * D, (float*)(ws + WS_PART), (const float*)nullptr, (const bf16*)(ws + WS_X)};
                pg8::gemm_phase<EpiResid, true>(lds, g, S, E, wv);
                if (L == 1) { const int fi = tail_first(256 + 32, G); bg_slot(ws, lds, 2, bid - fi, G - fi, false, 25, 37, wv); }
            }
            SEAM(pb + 7);
        }
        if (IN(pb + 8)) { WSP;
            phase_norm((const float*)nullptr, L == 0 ? inp(lds, I_CTX) : (const float*)nullptr, (bf16*)(ws + WS_X), (bf16*)(ws + WS_H), inp(lds, I_GFFN) + L * D, MODL, MODC, 3, 4, lds, ctx_out ? MT : SEQ, (const float*)(ws + WS_PART), 4, MODC + 2 * D, bid, G, wv);
            if (PROBE == 3) phase_norm((const float*)nullptr, (const float*)nullptr, (bf16*)(ws + WS_X), (bf16*)(ws + WS_H), inp(lds, I_GFFN) + L * D, MODL, MODC, 3, 4, lds, ctx_out ? MT : SEQ, (const float*)(ws + WS_PART), 0, MODC + 2 * D, bid, G, wv); }
        SEAM(pb + 8);
        if (IN(pb + 9)) { WSP;
            pg8::Gemm g = pg8::mk_gemm((const bf16*)(ws + WS_H) - D, (const bf16*)(ws + WS_WUP) + (size_t)L * DFF2 * D, D, D, D, (long)(SEQ + 1) * D, 0); g.tsA = (long)254 * D * 2;
            pg8::OrderSplit S; S.init(33, 44, 1, G, bid, g.K); if (ctx_out) S.extra(1, 0, 44, D, 1);
            EpiConvAct E{(bf16*)(ws + WS_ACT), inp(lds, I_FCW) + (size_t)L * 3 * DFF2, inp(lds, I_FCB) + (size_t)L * DFF2, (LAS float*)(lds + EX_OFF), (LAS float*)(lds + WB_OFF)};
            pg8::gemm_phase<EpiConvAct, true>(lds, g, S, E, wv);
            if (PROBE == 1) { __syncthreads(); pg8::gemm_phase<EpiConvAct, true>(lds, g, S, E, wv); }
            if (ctx_out) { const int fi = tail_first(33 * 44 + 44, G); bg_slot(ws, lds, L == 0 ? 0 : L + 1, bid - fi, G - fi, false, L == 0 ? 78 : (L == 1 ? 37 : 73), L == 0 ? 100 : (L == 1 ? 55 : 85), wv); }
            mod_final(ws, L + 1, bid, G, wv);
        }
        SEAM(pb + 9);
        if (IN(pb + 11)) { WSP;
            pg8::Gemm g = pg8::mk_gemm((const bf16*)(ws + WS_ACT), (const bf16*)(ws + WS_WDOWN) + (size_t)L * D * DFF, DFF, DFF, DFF, 0, 0); pg8::OrderSplit S; S.init(32, 8, 1, G, bid, g.K); if (ctx_out) S.extra(4, 32, 8, 1408);
            EpiResid E{(bf16*)(ws + WS_X), MODL + 5 * D, MODC + 5 * D, (float*)(ws + WS_PART), (const float*)nullptr, (const bf16*)(ws + WS_X)};
            pg8::gemm_phase<EpiResid, true>(lds, g, S, E, wv);
            if (ctx_out) { const int fi = tail_first(256 + 32, G); bg_slot(ws, lds, L + 1, bid - fi, G - fi, false, L == 0 ? 30 : (L == 1 ? 55 : 85), 100, wv); }
            if (PROBE == 16) { __syncthreads(); EpiResid E0{(bf16*)(ws + WS_X), (const float*)(ws + 524288), (const float*)(ws + 524288), (float*)(ws + WS_PART), (const float*)nullptr, (const bf16*)(ws + WS_X)}; pg8::gemm_phase<EpiResid, true>(lds, g, S, E0, wv); }
        }
        SEAM(pb + 11);
    }
    if (IN(PH_FINAL)) { WSP; phase_final((const bf16*)(ws + WS_X), a.out, inp(lds, I_GFINAL), bid, G, wv); }
#undef IN
#undef SEAM
#undef WSP
#undef MODL
#undef MODC
}

extern "C" void kernel_launch(void* const* d_in, const int* in_sizes, int n_in, void* d_out, int out_size, void* d_ws, size_t ws_size, hipStream_t stream) {
    static int grid = 0;
    if (grid == 0) {
        if (n_in != 25 || out_size != SEQ * D || ws_size < WS_END) { fprintf(stderr, "kernel_launch: unexpected shapes (n_in %d out %d ws %zu)\n", n_in, out_size, ws_size); grid = -1; return; }
        int dev = 0, cus = 0, per_cu = 0;
        if (hipGetDevice(&dev) != hipSuccess || hipDeviceGetAttribute(&cus, hipDeviceAttributeMultiprocessorCount, dev) != hipSuccess) { grid = -1; return; }
        if (hipFuncSetAttribute((const void*)fwd_kernel, hipFuncAttributeMaxDynamicSharedMemorySize, LDS_BYTES) != hipSuccess) { fprintf(stderr, "kernel_launch: hipFuncSetAttribute failed\n"); grid = -1; return; }
        if (hipOccupancyMaxActiveBlocksPerMultiprocessor(&per_cu, (const void*)fwd_kernel, NTHR, LDS_BYTES) != hipSuccess || per_cu < 1) fprintf(stderr, "kernel_launch: occupancy query says %d\n", per_cu);
        (void)hipGetLastError();
        grid = cus;
    }
    if (grid < 0) return;
    (void)hipMemsetAsync((char*)d_ws + WS_CTL, 0, CTL_ZERO_BYTES, stream);
    Args a{};
    for (int i = 0; i < 25; ++i) a.in[i] = (const float*)d_in[i];
    a.out = (float*)d_out; a.ws = (unsigned char*)d_ws;
#if MK_ONE_LAUNCH
    a.ph_lo = 0; a.ph_hi = PH_END;
    hipLaunchKernelGGL(fwd_kernel, dim3(grid), dim3(NTHR), LDS_BYTES, stream, a);
#else
    for (int p = 0; p < PH_END; ++p) {
        if (p >= 2 && p < PH_FINAL) { const int L = (p - 2) >> 4, k = (p - 2) & 15; const bool fa = (L & 1) == 0;
            const bool used = fa ? (k <= 5 || (k >= 8 && k <= 11)) : (k <= 7 || (k >= 8 && k <= 11)); if (!used) continue; }
        a.ph_lo = p; a.ph_hi = p + 1;
        hipLaunchKernelGGL(fwd_kernel, dim3(grid), dim3(NTHR), LDS_BYTES, stream, a);
    }
#endif
}
```

```cpp
#include <hip/hip_runtime.h>
#include <cstdio>
#include <cstdint>
#include <cmath>

#ifndef PROBE
#define PROBE 0
#endif
#ifndef MK_ONE_LAUNCH
#define MK_ONE_LAUNCH 1
#endif

namespace pg8 {
#define PG8_LAS __attribute__((address_space(3)))
typedef unsigned short bf16_t;
typedef short bf16x8 __attribute__((ext_vector_type(8)));
typedef float f32x4 __attribute__((ext_vector_type(4)));
typedef unsigned u32x4 __attribute__((ext_vector_type(4)));
typedef unsigned u32x2 __attribute__((ext_vector_type(2)));
constexpr int BM = 256, BK = 64, HALF = 128, HTB = HALF * BK * 2, STAGE_BYTES = 8 * HTB, NXCD = 8, WGM = 4;

__host__ __device__ __forceinline__ int lds_byte(int r, int c) { const int st = (r >> 4) * 2 + (c >> 5), rr = r & 15, cc = c & 31, ob = rr * 64 + cc * 2; return st * 1024 + (ob ^ (((ob >> 9) & 1) << 5)); }
__host__ __device__ __forceinline__ void stage_rc(int b, int& R, int& C) { const int st = b / 1024, sb = b % 1024, swz = sb ^ (((sb >> 9) & 1) << 5); R = (st >> 1) * 16 + swz / 64; C = (st & 1) * 32 + (swz % 64) / 2; }
__host__ __device__ __forceinline__ int perm32(int rho) { const int n = rho >> 4, i = rho & 15; return 8 * (i >> 2) + 4 * n + (i & 3); }

struct Unit { int pm, pn, pb, k0, nt, ks, par; };
struct Gemm { const bf16_t* A; const bf16_t* Bt; int lda, ldb, K; long sA, sB;
    int rmB; long hsB, tsB, tsA; };
__device__ __forceinline__ Gemm mk_gemm(const bf16_t* A, const bf16_t* Bt, int lda, int ldb, int K, long sA, long sB) { Gemm g; g.A = A; g.Bt = Bt; g.lda = lda; g.ldb = ldb; g.K = K; g.sA = sA; g.sB = sB; g.rmB = 1; g.hsB = (long)HALF * ldb * 2; g.tsB = 2 * g.hsB; g.tsA = (long)BM * lda * 2; return g; }

template <bool SPLIT> struct OrderT {
    int nM, nN, nB, nwg, G, c, ntf;
    int nx, xpm, xN, xK, xpb;
    __device__ __forceinline__ void init(int nM_, int nN_, int nB_, int G_, int c_, int K_) { nM = nM_; nN = nN_; nB = nB_; nwg = nM * nN * nB; G = G_; c = c_; ntf = K_ / BK; nx = 0; xpm = 0; xN = 1; xK = 0; xpb = 0; }
    __device__ __forceinline__ void extra(int nslices, int pm_, int nN_, int K_, int pb_ = 0) { nx = nslices * nN_; xpm = pm_; xN = nN_; xK = K_; xpb = pb_; }
    __device__ __forceinline__ bool next(int i, Unit& u) const {
        const long L = (long)i * G + c; if (L >= nwg + (SPLIT ? nx : 0)) return false;
        const bool ex = SPLIT && L >= nwg;
        const int sidx = ex ? (int)L - nwg : 0;
        int wgid = ex ? 0 : (int)L; { const int q = nwg / NXCD, r = nwg % NXCD, xcd = wgid % NXCD, off = wgid / NXCD; wgid = (xcd < r ? xcd * (q + 1) : r * (q + 1) + (xcd - r) * q) + off; }
        const int per = nM * nN; const int pb_ = wgid / per; const int w = wgid % per;
        const int nig = WGM * nN, gid = w / nig, fm = gid * WGM, gsz = (nM - fm) < WGM ? (nM - fm) : WGM;
        const int pm_ = fm + ((w % nig) % gsz), pn_ = (w % nig) / gsz;
        const int xn = SPLIT ? xN : 1;
        u.pm = ex ? xpm : pm_; u.pn = ex ? sidx % xn : pn_; u.pb = ex ? (SPLIT ? xpb : 0) : pb_;
        u.ks = ex ? sidx / xn : -1; u.k0 = ex ? (sidx / xn) * xK : 0; u.nt = ex ? xK / BK : ntf;
        return true;
    }
};
typedef OrderT<false> Order; typedef OrderT<true> OrderSplit;

__device__ __forceinline__ unsigned cvt_pk_bf16(float lo, float hi) { unsigned r; asm volatile("v_cvt_pk_bf16_f32 %0, %1, %2" : "=v"(r) : "v"(lo), "v"(hi)); return r; }

template <class Epi> __device__ __forceinline__ constexpr auto permA_sel(int R, int) -> decltype(Epi::PERMA, int()) { return Epi::PERMA ? ((R & ~63) | ((R & 15) << 2) | ((R >> 4) & 3)) : R; }
template <class Epi> __device__ __forceinline__ constexpr int permA_sel(int R, long) { return R; }
template <class Epi> __device__ __forceinline__ constexpr int permA(int R) { return permA_sel<Epi>(R, 0); }
template <class Epi> __device__ __forceinline__ constexpr auto has_pref(int) -> decltype(Epi::PREFETCH, bool()) { return Epi::PREFETCH; }
template <class Epi> __device__ __forceinline__ constexpr bool has_pref(long) { return false; }
template <class Epi, bool ALIGN_EPI, class Sched>
__device__ __forceinline__ void gemm_phase(PG8_LAS unsigned char* lds, const Gemm g, const Sched& S, const Epi& E, int wv) {
    int lz = 0; asm volatile("" : "+v"(lz)); const int lane = (int)__builtin_amdgcn_mbcnt_hi(~0u, __builtin_amdgcn_mbcnt_lo(~0u, (unsigned)lz)), tid = wv * 64 + lane;
    const int wid = wv, wr = wid >> 2, wc = wid & 3, fr = lane & 15, fq = lane >> 4;
    const __attribute__((address_space(1))) bf16_t* gAg = (const __attribute__((address_space(1))) bf16_t*)g.A; const __attribute__((address_space(1))) bf16_t* gBg = (const __attribute__((address_space(1))) bf16_t*)g.Bt; asm volatile("" : "+s"(gAg), "+s"(gBg));
    const bf16_t* gA = (const bf16_t*)gAg; const bf16_t* gB = (const bf16_t*)gBg;
    unsigned voffA[2], voffB[2];
#pragma unroll
    for (int i = 0; i < 2; ++i) { int R, C; stage_rc(tid * 16 + i * 8192, R, C); const int Rb = Epi::PERM ? ((R & ~31) + perm32(R & 31)) : R;
        const int Ra = permA<Epi>(R); voffA[i] = (unsigned)(Ra * g.lda + C) * 2u; voffB[i] = (unsigned)(Rb * g.rmB * g.ldb + C) * 2u; }
    const size_t kstep = (size_t)(BK * 2);
    const size_t hstepA = (size_t)HALF * g.lda * 2, hstepB = (size_t)g.hsB;
    const unsigned ldsw = (unsigned)wid * 1024u;
    const int aoff = lds_byte(wr * 64 + fr, fq * 8), boff = lds_byte(wc * 32 + fr, fq * 8);
#define PG8_SA(b, h) (((b) * 2 + (h)) * HTB)
#define PG8_SB(b, h) ((4 + (b) * 2 + (h)) * HTB)
#define PG8_STAGE(bufoff, gbase, voff) do { _Pragma("unroll") for (int _i = 0; _i < 2; ++_i) { unsigned _v = (voff)[_i]; asm volatile("" : "+v"(_v));   \
        __builtin_amdgcn_global_load_lds((const unsigned*)((const char*)(gbase) + _v), (PG8_LAS unsigned*)(lds + (bufoff) + ldsw + _i * 8192), 16, 0, 0); } } while (0)
#define PG8_LDA(dst, b, h) do { _Pragma("unroll") for (int m = 0; m < 4; ++m) _Pragma("unroll") for (int k = 0; k < 2; ++k) dst[m][k] = *(const PG8_LAS bf16x8*)(lds + PG8_SA(b, h) + aoff + m * 2048 + k * 1024); } while (0)
#define PG8_LDB(dst, b, h) do { _Pragma("unroll") for (int n = 0; n < 2; ++n) _Pragma("unroll") for (int k = 0; k < 2; ++k) dst[n][k] = *(const PG8_LAS bf16x8*)(lds + PG8_SB(b, h) + boff + n * 2048 + k * 1024); } while (0)
#define PG8_MMA(ai, bj, At, Bt) do { __builtin_amdgcn_s_setprio(1); _Pragma("unroll") for (int m = 0; m < 4; ++m) _Pragma("unroll") for (int n = 0; n < 2; ++n) _Pragma("unroll") for (int k = 0; k < 2; ++k) \
        acc[ai][bj][m][n] = __builtin_amdgcn_mfma_f32_16x16x32_bf16(Bt[n][k], At[m][k], acc[ai][bj][m][n], 0, 0, 0); __builtin_amdgcn_s_setprio(0); } while (0)
#define PG8_WAIT_V(n) asm volatile("s_waitcnt vmcnt(" #n ")" ::: "memory")
#define PG8_WAIT_L(n) asm volatile("s_waitcnt lgkmcnt(" #n ")" ::: "memory")
#define PG8_BAR __builtin_amdgcn_s_barrier()
#define PG8_SCHED __builtin_amdgcn_sched_barrier(0)
    auto PG8_WR = [&]() { int w_ = wr; asm volatile("" : "+s"(w_)); return w_; };
    Unit cur, nxt; int ui = 0;
    if (!S.next(0, cur)) return;
    f32x4 acc[2][2][4][2];
#pragma unroll
    for (int a = 0; a < 2; ++a)
#pragma unroll
        for (int b = 0; b < 2; ++b)
#pragma unroll
            for (int m = 0; m < 4; ++m)
#pragma unroll
                for (int n = 0; n < 2; ++n) acc[a][b][m][n] = (f32x4){0.f, 0.f, 0.f, 0.f};
    bf16x8 At[4][2], B0[2][2], B1[2][2];
    const char* cA = (const char*)(gA + (size_t)cur.pb * g.sA + cur.k0) + (size_t)cur.pm * g.tsA;
    const char* cB = (const char*)(gB + (size_t)cur.pb * g.sB + cur.k0) + (size_t)cur.pn * g.tsB;
    if constexpr (has_pref<Epi>(0)) E.prefetch(cur, 0, wid, lane);
    PG8_STAGE(PG8_SB(0, 0), cB, voffB); PG8_STAGE(PG8_SB(0, 1), cB + hstepB, voffB); PG8_STAGE(PG8_SA(0, 0), cA, voffA); PG8_STAGE(PG8_SA(0, 1), cA + hstepA, voffA);
    if (PG8_WR() == 1) PG8_BAR;
    PG8_WAIT_V(2); PG8_BAR;
    PG8_STAGE(PG8_SB(1, 0), cB + kstep, voffB); PG8_STAGE(PG8_SA(1, 0), cA + kstep, voffA); PG8_STAGE(PG8_SB(1, 1), cB + hstepB + kstep, voffB);
    PG8_WAIT_V(6); PG8_BAR;
    for (;;) {
        const bool has_next = S.next(ui + 1, nxt);
        const char* nA = has_next ? (const char*)(gA + (size_t)nxt.pb * g.sA + nxt.k0) + (size_t)nxt.pm * g.tsA : cA;
        const char* nB = has_next ? (const char*)(gB + (size_t)nxt.pb * g.sB + nxt.k0) + (size_t)nxt.pn * g.tsB : cB;
        int nt = __builtin_amdgcn_readfirstlane(cur.nt); asm volatile("" : "+s"(nt));
        for (int t = 0; t < nt; t += 2) {
            const bool last = (t == nt - 2);
            const char* a1 = cA + (size_t)(t + 1) * kstep;
            const char* a2 = last ? nA : cA + (size_t)(t + 2) * kstep; const char* b2 = last ? nB : cB + (size_t)(t + 2) * kstep;
            const char* a3 = a2 + kstep; const char* b3 = b2 + kstep;
            PG8_LDB(B0, 0, 0); PG8_LDB(B1, 0, 1); PG8_SCHED; PG8_LDA(At, 0, 0); PG8_STAGE(PG8_SA(1, 1), a1 + hstepA, voffA);
            PG8_WAIT_V(8); PG8_WAIT_L(0); PG8_BAR; PG8_MMA(0, 0, At, B0); PG8_MMA(0, 1, At, B1); PG8_BAR; PG8_SCHED;
            PG8_LDA(At, 0, 1); PG8_STAGE(PG8_SB(0, 0), b2, voffB); PG8_STAGE(PG8_SB(0, 1), b2 + hstepB, voffB); PG8_STAGE(PG8_SA(0, 0), a2, voffA);
            PG8_WAIT_V(8); PG8_WAIT_L(0); PG8_BAR; PG8_MMA(1, 0, At, B0); PG8_MMA(1, 1, At, B1); PG8_BAR; PG8_SCHED;
            PG8_LDB(B0, 1, 0); PG8_LDB(B1, 1, 1); PG8_SCHED; PG8_LDA(At, 1, 0); PG8_STAGE(PG8_SA(0, 1), a2 + hstepA, voffA);
            PG8_WAIT_V(8); PG8_WAIT_L(0); PG8_BAR; PG8_MMA(0, 0, At, B0); PG8_MMA(0, 1, At, B1); PG8_BAR; PG8_SCHED;
            PG8_LDA(At, 1, 1); PG8_STAGE(PG8_SB(1, 0), b3, voffB); PG8_STAGE(PG8_SB(1, 1), b3 + hstepB, voffB); PG8_STAGE(PG8_SA(1, 0), a3, voffA);
            PG8_WAIT_V(8); PG8_WAIT_L(0); PG8_BAR; PG8_MMA(1, 0, At, B0); PG8_MMA(1, 1, At, B1); PG8_BAR; PG8_SCHED;
        }
        if constexpr (ALIGN_EPI) { if (PG8_WR() == 0) PG8_BAR; }
        { int fr2 = fr, fq2 = fq; asm volatile("" : "+v"(fr2), "+v"(fq2)); cur.par = ui & 1; E(acc, cur, wr, wc, fr2, fq2); }
        if constexpr (has_pref<Epi>(0)) { if (has_next) E.prefetch(nxt, (ui + 1) & 1, wid, lane); }
        if (!has_next) break;
#pragma unroll
        for (int a = 0; a < 2; ++a)
#pragma unroll
            for (int b = 0; b < 2; ++b)
#pragma unroll
                for (int m = 0; m < 4; ++m)
#pragma unroll
                    for (int n = 0; n < 2; ++n) acc[a][b][m][n] = (f32x4){0.f, 0.f, 0.f, 0.f};
        cur = nxt; cA = nA; cB = nB; ++ui;
        if constexpr (ALIGN_EPI) { if (PG8_WR() == 1) PG8_BAR; }
    }
    PG8_WAIT_V(0);
    if constexpr (!ALIGN_EPI) { if (PG8_WR() == 0) PG8_BAR; }
    PG8_BAR;
#undef PG8_SA
#undef PG8_SB
#undef PG8_STAGE
#undef PG8_LDA
#undef PG8_LDB
#undef PG8_MMA
#undef PG8_WAIT_V
#undef PG8_WAIT_L
#undef PG8_BAR
#undef PG8_SCHED
}
}

constexpr float LOG2E = 1.4426950408889634f;
constexpr int NWAVES = 8, NTHR = NWAVES * 64;
constexpr int D = 2048, SEQ = 8192, CTXL = 256, MT = SEQ + CTXL, DEPTH = 4;
constexpr int FA_IN = 2304, DFF = 5632, DFF2 = 11264, NMOD6 = 6 * D;
constexpr float EPS = 1e-6f;

constexpr size_t MiB = 1u << 20;
constexpr size_t WS_CTL = 0, CTL_ZERO_BYTES = 1 * MiB;
constexpr size_t WS_MODP = 364 * MiB;
constexpr size_t WS_MOD = 4 * MiB;
constexpr size_t WS_ROPE = 5 * MiB;
constexpr size_t WS_SP8 = 5 * MiB + 65536;
constexpr size_t WS_DFTC = 6 * MiB;
constexpr size_t WS_DFTNC = 7 * MiB;
constexpr size_t WS_DA = 7 * MiB + 262144;
constexpr size_t WS_DB4 = 7 * MiB + 393216;
constexpr size_t WS_TW = 7 * MiB + 655360;
constexpr size_t WS_SCAN = 1212 * MiB;
constexpr size_t WS_WGATE = 10 * MiB;
constexpr size_t WS_WINFA = 18 * MiB;
constexpr size_t WS_WOUTFA = 36 * MiB;
constexpr size_t WS_WINRG = 52 * MiB;
constexpr size_t WS_WOUTRG = 84 * MiB;
constexpr size_t WS_WUP = 100 * MiB;
constexpr size_t WS_WDOWN = 276 * MiB;
constexpr size_t WS_DFTN = 364 * MiB;
constexpr size_t WS_X = 620 * MiB;
constexpr size_t WS_H = 686 * MiB;
constexpr size_t WS_TMP = 719 * MiB;
constexpr size_t WS_U = WS_TMP, WS_ACT = 901 * MiB;
constexpr size_t WS_LG = WS_TMP;
constexpr size_t WS_F = WS_TMP, WS_Q = 736 * MiB, WS_KB = 753 * MiB, WS_VB = 756 * MiB, WS_VT = 759 * MiB, WS_VTC = 791 * MiB, WS_ZP = 792 * MiB;
constexpr size_t WS_Z = 992 * MiB;
constexpr size_t WS_GATE = 1025 * MiB;
constexpr size_t WS_XS = 1058 * MiB;
constexpr size_t WS_XSC = 1091 * MiB;
constexpr size_t WS_HF = 1124 * MiB;
constexpr size_t WS_PART = 1190 * MiB;
constexpr size_t WS_PART2 = 1220 * MiB;
constexpr size_t WS_END = 1254 * MiB;
constexpr int CW_BAR = 4096;
constexpr int CW_BGT = 8192, CW_BGM = 8704;

constexpr int RING_BYTES = 131072;
constexpr int MISC_OFF = RING_BYTES + 320, PTAB_OFF = RING_BYTES + 1024, EX_OFF = RING_BYTES + 4096, WB_OFF = RING_BYTES + 12288;
constexpr int LDS_BYTES = 151552;

#define GAS __attribute__((address_space(1)))
#define LAS __attribute__((address_space(3)))
typedef unsigned short bf16;
typedef unsigned v4u __attribute__((ext_vector_type(4)));
typedef unsigned v2u __attribute__((ext_vector_type(2)));
typedef float f32x4 __attribute__((ext_vector_type(4)));
typedef float f32x16 __attribute__((ext_vector_type(16)));
typedef short bf16x8 __attribute__((ext_vector_type(8)));
typedef short s16x4 __attribute__((ext_vector_type(4)));
typedef GAS unsigned gu32;

__device__ __forceinline__ int otid(int wv) { int z = 0; asm volatile("" : "+v"(z)); return wv * 64 + (int)__builtin_amdgcn_mbcnt_hi(~0u, __builtin_amdgcn_mbcnt_lo(~0u, (unsigned)z)); }
__device__ __forceinline__ int obid() { int b = blockIdx.x; asm volatile("" : "+s"(b)); return b; }
__device__ __forceinline__ int ogrid() { int b = gridDim.x; asm volatile("" : "+s"(b)); return b; }
__device__ __forceinline__ bool in_range(int lo, int hi, int k) { asm volatile("" : "+s"(lo), "+s"(hi)); return lo <= k && k < hi; }
__device__ __forceinline__ unsigned f2bf(float f) { unsigned u = __builtin_bit_cast(unsigned, f); return (u + 0x7fffu + ((u >> 16) & 1u)) >> 16; }
__device__ __forceinline__ unsigned pk2(float lo, float hi) { unsigned r; asm("v_cvt_pk_bf16_f32 %0, %1, %2" : "=v"(r) : "v"(lo), "v"(hi)); return r; }
__device__ __forceinline__ float bflo(unsigned w) { return __builtin_bit_cast(float, w << 16); }
__device__ __forceinline__ float bfhi(unsigned w) { return __builtin_bit_cast(float, w & 0xffff0000u); }
__device__ __forceinline__ float bf2f(bf16 h) { return __builtin_bit_cast(float, (unsigned)h << 16); }
__device__ __forceinline__ float lane_xor(float v, int lane, int o) { return __builtin_bit_cast(float, __builtin_amdgcn_ds_bpermute((lane ^ o) << 2, __builtin_bit_cast(int, v))); }
__device__ __forceinline__ float max3_(float a, float b, float c) { float d; asm("v_max3_f32 %0, %1, %2, %3" : "=v"(d) : "v"(a), "v"(b), "v"(c)); return d; }
__device__ __forceinline__ float wave_sum(float v, int lane) {
#pragma unroll
    for (int o = 1; o < 64; o <<= 1) v += lane_xor(v, lane, o);
    return v;
}
__device__ __forceinline__ float fexp(float x) { return __builtin_amdgcn_exp2f(x * 1.4426950408889634f); }
__device__ __forceinline__ float frcp(float x) { return __builtin_amdgcn_rcpf(x); }
__device__ __forceinline__ float sigmoidf_(float x) { return frcp(1.0f + fexp(-x)); }
__device__ __forceinline__ float siluf_(float x) { return x * frcp(1.0f + fexp(-x)); }
__device__ __forceinline__ float gelu_tanh(float x) { const float u = 0.7978845608028654f * (x + 0.044715f * x * x * x); return x * frcp(1.0f + fexp(-2.0f * u)); }

#define XB_TMO      128
#define XB_XCNT(j)  (256  + 64 * (j))
#define XB_XSUB(j)  (1280 + 64 * (j))
#define XB_XGEN(j)  (2304 + 64 * (j))
#define XB_TOP      3328
#define XB_TOPGEN   3392
#define XCD_BAR_WORDS 3456
#define XB_SPIN_CAP (1u << 18)
__device__ __forceinline__ unsigned xb_ld(unsigned* p)              { return __hip_atomic_load(p, __ATOMIC_RELAXED, __HIP_MEMORY_SCOPE_AGENT); }
__device__ __forceinline__ unsigned xb_add(unsigned* p, unsigned v) { return __hip_atomic_fetch_add(p, v, __ATOMIC_RELAXED, __HIP_MEMORY_SCOPE_AGENT); }
__device__ __forceinline__ unsigned xb_xcc_id() { return (unsigned)__builtin_amdgcn_s_getreg((3 << 11) | 20) & 0xFu; }
#define XB_SPIN(cond, bar) do { unsigned _sp = 0; while (cond) { __builtin_amdgcn_s_sleep(1); \
    if ((++_sp & 255u) == 0u) { if (xb_ld(&(bar)[XB_TMO])) break; if (_sp > XB_SPIN_CAP) { atomicAdd(&(bar)[XB_TMO], 1u); break; } } } } while (0)
struct XcdBarrier { unsigned* bar; unsigned x; volatile LAS unsigned* st; };
__device__ __forceinline__ XcdBarrier xcd_barrier_post(unsigned* bar, volatile LAS unsigned* st) {
    XcdBarrier b; b.bar = bar; b.x = xb_xcc_id(); b.st = st;
    if (threadIdx.x == 0) (void)xb_add(&bar[XB_XCNT(b.x)], 1u);
    return b;
}
__device__ __forceinline__ void xcd_barrier_complete(unsigned* bar, unsigned x, unsigned& nloc, unsigned& nx) {
    const unsigned G = gridDim.x * gridDim.y * gridDim.z;
    unsigned sum, cnt, mine, sp = 0u;
    for (;;) {
        sum = 0u; cnt = 0u; mine = 0u;
#pragma unroll
        for (unsigned j = 0; j < 16; ++j) { const unsigned c = xb_ld(&bar[XB_XCNT(j)]); sum += c; cnt += (c > 0u) ? 1u : 0u; mine = (j == x) ? c : mine; }
        if (sum == G) break;
        __builtin_amdgcn_s_sleep(1);
        if ((++sp & 255u) == 0u) { if (xb_ld(&bar[XB_TMO])) break; if (sp > XB_SPIN_CAP) { atomicAdd(&bar[XB_TMO], 1u); break; } }
    }
    nloc = mine > 0u ? mine : 1u; nx = cnt > 0u ? cnt : 1u;
}
__device__ __forceinline__ void xcd_barrier(const XcdBarrier& b, int wv) {
    asm volatile("s_waitcnt vmcnt(0)" ::: "memory");
    __syncthreads();
    unsigned bx = b.x; asm volatile("" : "+v"(bx));
    if (otid(wv) == 0) {
        unsigned* bar = b.bar;
        __builtin_amdgcn_s_waitcnt(0);
        unsigned nloc = b.st[0], nx = b.st[1];
        if (nloc == 0u) { xcd_barrier_complete(bar, bx, nloc, nx); b.st[0] = nloc; b.st[1] = nx; }
        const unsigned old = xb_add(&bar[XB_XSUB(bx)], 1u);
        const unsigned gen = old / nloc;
        if (old + 1u == (gen + 1u) * nloc) {
            __builtin_amdgcn_fence(__ATOMIC_RELEASE, "agent");
            asm volatile("s_waitcnt vmcnt(0)" ::: "memory");
            const unsigned og = xb_add(&bar[XB_TOP], 1u);
            const unsigned tg = og / nx;
            if (og + 1u == (tg + 1u) * nx) xb_add(&bar[XB_TOPGEN], 1u);
            else XB_SPIN(xb_ld(&bar[XB_TOPGEN]) == tg, bar);
            __builtin_amdgcn_fence(__ATOMIC_ACQUIRE, "agent");
            xb_add(&bar[XB_XGEN(bx)], 1u);
            asm volatile("s_waitcnt vmcnt(0)" ::: "memory");
        } else {
            XB_SPIN(xb_ld(&bar[XB_XGEN(bx)]) == gen, bar);
            __builtin_amdgcn_fence(__ATOMIC_ACQUIRE, "agent");
            asm volatile("s_waitcnt vmcnt(0)" ::: "memory");
        }
    }
    __syncthreads();
}

using pg8::Unit;
struct EpiStore {
    static constexpr bool PERM = true;
    bf16* O; int ldc; long sC; int split_tiles; long split_stride; float scale;
    __device__ __forceinline__ void operator()(const f32x4 (&acc)[2][2][4][2], const Unit& u, int wr, int wc, int fr, int fq) const {
        const int row0 = u.pm * 256 + wr * 64 + fr; int pn = u.pn; bf16* base = O + (size_t)u.pb * sC;
        if (split_tiles) { const int t = pn / split_tiles; base += (size_t)t * split_stride; pn -= t * split_tiles; }
        const int col0 = pn * 256 + wc * 32 + 8 * fq;
#pragma unroll
        for (int ai = 0; ai < 2; ++ai)
#pragma unroll
            for (int m = 0; m < 4; ++m) { bf16* rowp = base + (size_t)(row0 + ai * 128 + m * 16) * ldc + col0;
#pragma unroll
                for (int bj = 0; bj < 2; ++bj) { const f32x4 v0 = acc[ai][bj][m][0] * scale, v1 = acc[ai][bj][m][1] * scale;
                    v4u w; w.x = pg8::cvt_pk_bf16(v0[0], v0[1]); w.y = pg8::cvt_pk_bf16(v0[2], v0[3]); w.z = pg8::cvt_pk_bf16(v1[0], v1[1]); w.w = pg8::cvt_pk_bf16(v1[2], v1[3]);
                    *(v4u*)(rowp + bj * 128) = w; } }
    }
};
struct EpiRgIn {
    static constexpr bool PERM = true;
    bf16* GATE; bf16* XS; float* PART2;
    __device__ __forceinline__ void operator()(const f32x4 (&acc)[2][2][4][2], const Unit& u, int wr, int wc, int fr, int fq) const {
        if (u.ks >= 0) {
            const int col0 = u.pn * 256 + wc * 32 + 8 * fq;
#pragma unroll
            for (int ai = 0; ai < 2; ++ai)
#pragma unroll
                for (int m = 0; m < 4; ++m) { float* p = PART2 + ((size_t)u.ks * 256 + ai * 128 + wr * 64 + m * 16 + fr) * 4096 + col0;
#pragma unroll
                    for (int bj = 0; bj < 2; ++bj) { *(f32x4*)(p + bj * 128) = acc[ai][bj][m][0]; *(f32x4*)(p + bj * 128 + 4) = acc[ai][bj][m][1]; } }
            return;
        }
        const int row0 = u.pm * 256 + wr * 64 + fr; bf16* base = u.pn < 8 ? GATE : XS; const int col0 = (u.pn & 7) * 256 + wc * 32 + 8 * fq;
#pragma unroll
        for (int ai = 0; ai < 2; ++ai)
#pragma unroll
            for (int m = 0; m < 4; ++m) { bf16* rowp = base + (size_t)(row0 + ai * 128 + m * 16) * D + col0;
#pragma unroll
                for (int bj = 0; bj < 2; ++bj) { const f32x4 v0 = acc[ai][bj][m][0], v1 = acc[ai][bj][m][1];
                    v4u w; w.x = pg8::cvt_pk_bf16(v0[0], v0[1]); w.y = pg8::cvt_pk_bf16(v0[2], v0[3]); w.z = pg8::cvt_pk_bf16(v1[0], v1[1]); w.w = pg8::cvt_pk_bf16(v1[2], v1[3]);
                    *(v4u*)(rowp + bj * 128) = w; } }
    }
};
struct EpiX3 {
    static constexpr bool PERM = true;
    bf16* X3;
    __device__ __forceinline__ void operator()(const f32x4 (&acc)[2][2][4][2], const Unit& u, int wr, int wc, int fr, int fq) const {
#pragma unroll
        for (int ai = 0; ai < 2; ++ai)
#pragma unroll
            for (int m = 0; m < 4; ++m) { const int r = u.pm * 256 + ai * 128 + wr * 64 + m * 16 + fr; const int mch = r >> 1, sgn = r & 1;
#pragma unroll
                for (int bj = 0; bj < 2; ++bj) { const int n2 = 2 * u.pn + bj, n1 = wc * 32 + 8 * fq;
                    bf16* dst = X3 + ((size_t)((u.pb * 256 + mch) * 64 + n2)) * 256 + sgn * 128 + n1;
                    const f32x4 v0 = acc[ai][bj][m][0], v1 = acc[ai][bj][m][1];
                    v4u w; w.x = pg8::cvt_pk_bf16(v0[0], v0[1]); w.y = pg8::cvt_pk_bf16(v0[2], v0[3]); w.z = pg8::cvt_pk_bf16(v1[0], v1[1]); w.w = pg8::cvt_pk_bf16(v1[2], v1[3]);
                    *(v4u*)dst = w; } }
    }
};
struct EpiTw {
    static constexpr bool PERM = true;
    bf16* ZP; const float* twc; const float* tws;
    __device__ __forceinline__ void operator()(const f32x4 (&acc)[2][2][4][2], const Unit& u, int wr, int wc, int fr, int fq) const {
        f32x4 cw[4][2][2], sw[4][2][2];
#pragma unroll
        for (int m = 0; m < 4; ++m) { const int k1 = wr * 64 + m * 16 + fr;
#pragma unroll
            for (int bj = 0; bj < 2; ++bj) { const int n2 = (bj * 128 + wc * 32 + 8 * fq) & 63;
                cw[m][bj][0] = *(const f32x4*)(twc + k1 * 64 + n2); cw[m][bj][1] = *(const f32x4*)(twc + k1 * 64 + n2 + 4);
                sw[m][bj][0] = *(const f32x4*)(tws + k1 * 64 + n2); sw[m][bj][1] = *(const f32x4*)(tws + k1 * 64 + n2 + 4); } }
#pragma unroll
        for (int m = 0; m < 4; ++m) { const int k1 = wr * 64 + m * 16 + fr;
#pragma unroll
            for (int bj = 0; bj < 2; ++bj) { const int colg = u.pn * 256 + bj * 128 + wc * 32 + 8 * fq; const int gm = colg >> 6, n2 = colg & 63;
                bf16* dst = ZP + ((size_t)gm * 128 + k1) * 128 + n2;
                v4u wr_, wi_;
#pragma unroll
                for (int n = 0; n < 2; ++n) { const f32x4 zr = acc[0][bj][m][n], zi = acc[1][bj][m][n], c = cw[m][bj][n], sn = sw[m][bj][n];
                    const f32x4 yr = zr * c + zi * sn, yi = zi * c - zr * sn;
                    if (n == 0) { wr_.x = pg8::cvt_pk_bf16(yr[0], yr[1]); wr_.y = pg8::cvt_pk_bf16(yr[2], yr[3]); wi_.x = pg8::cvt_pk_bf16(yi[0], yi[1]); wi_.y = pg8::cvt_pk_bf16(yi[2], yi[3]); }
                    else { wr_.z = pg8::cvt_pk_bf16(yr[0], yr[1]); wr_.w = pg8::cvt_pk_bf16(yr[2], yr[3]); wi_.z = pg8::cvt_pk_bf16(yi[0], yi[1]); wi_.w = pg8::cvt_pk_bf16(yi[2], yi[3]); } }
                *(v4u*)dst = wr_; *(v4u*)(dst + 64) = wi_; } }
    }
};
struct EpiFftOut {
    static constexpr bool PERM = true;
    bf16* Z; float scale;
    __device__ __forceinline__ void operator()(const f32x4 (&acc)[2][2][4][2], const Unit& u, int wr, int wc, int fr, int fq) const {
        const int col0 = u.pn * 256 + wc * 32 + 8 * fq;
#pragma unroll
        for (int ai = 0; ai < 2; ++ai)
#pragma unroll
            for (int m = 0; m < 4; ++m) { const int tok = 4 * u.pb + 2 * ai + wr + 128 * (16 * m + fr); bf16* rowp = Z + (size_t)tok * D + col0;
#pragma unroll
                for (int bj = 0; bj < 2; ++bj) { const f32x4 v0 = acc[ai][bj][m][0] * scale, v1 = acc[ai][bj][m][1] * scale;
                    v4u w; w.x = pg8::cvt_pk_bf16(v0[0], v0[1]); w.y = pg8::cvt_pk_bf16(v0[2], v0[3]); w.z = pg8::cvt_pk_bf16(v1[0], v1[1]); w.w = pg8::cvt_pk_bf16(v1[2], v1[3]);
                    *(v4u*)(rowp + bj * 128) = w; } }
    }
};
template <int CTRL> __device__ __forceinline__ float dpp_zero(float src) { return __builtin_bit_cast(float, __builtin_amdgcn_update_dpp(0, __builtin_bit_cast(int, src), CTRL, 0xf, 0xf, true)); }
template <int CTRL> __device__ __forceinline__ float dpp_mov(float old, float src) { return __builtin_bit_cast(float, __builtin_amdgcn_update_dpp(__builtin_bit_cast(int, old), __builtin_bit_cast(int, src), CTRL, 0xf, 0xf, false)); }
struct EpiConvAct {
    static constexpr bool PERM = true, PERMA = true, PREFETCH = true;
    bf16* ACT; const float* cw; const float* cb; PG8_LAS float* EX; PG8_LAS float* WB;
    __device__ __forceinline__ void prefetch(const Unit& u, int par, int wid, int lane) const {
        if (wid >= 4) return;
        const int a = wid * 2 + (lane >> 5), piece = lane & 31, isv = a >> 2, k = a & 3;
        const float* src = (k < 3 ? cw + (size_t)k * DFF2 : cb) + isv * DFF + u.pn * 128 + piece * 4;
        __builtin_amdgcn_global_load_lds((const unsigned*)src, (PG8_LAS unsigned*)(WB + par * 1024 + wid * 256), 16, 0, 0);
    }
    __device__ __forceinline__ void operator()(const f32x4 (&acc)[2][2][4][2], const Unit& u, int wr, int wc, int fr, int fq) const {
        const bool ctx = u.ks >= 0;
        const int c0 = u.pn * 128 + wc * 32 + 8 * fq;
        const int grow0 = ctx ? SEQ : 254 * u.pm - 1;
#pragma unroll
        for (int ai = 0; ai < 2; ++ai) { const int blk = ai * 2 + wr;
            const bool first = fr == 0;
            if (fr == 0 || fr == 15) { PG8_LAS float* e = EX + ((blk * 4 + wc) * 2 + (first ? 0 : 1)) * 64 + fq * 16;
#pragma unroll
                for (int bj = 0; bj < 2; ++bj)
#pragma unroll
                    for (int n = 0; n < 2; ++n) { const f32x4 a0 = acc[ai][bj][0][n], a3 = acc[ai][bj][3][n]; f32x4 v;
#pragma unroll
                        for (int i = 0; i < 4; ++i) v[i] = first ? a0[i] : a3[i];
                        *(PG8_LAS f32x4*)(e + bj * 8 + 4 * n) = v; } } }
        asm volatile("s_waitcnt lgkmcnt(0)" ::: "memory"); __builtin_amdgcn_s_barrier(); asm volatile("" ::: "memory");
        if (ctx) conv_body<true>(acc, u.par, wr, wc, fr, fq, c0, grow0, 0, 255, 0, 255);
        else if (u.pm == 0) conv_body<true>(acc, u.par, wr, wc, fr, fq, c0, grow0, 1, 1 << 20, 1, 254);
        else if (u.pm == 32) conv_body<true>(acc, u.par, wr, wc, fr, fq, c0, grow0, -(1 << 20), SEQ - 1 - grow0, 1, SEQ - 1 - grow0);
        else conv_body<false>(acc, u.par, wr, wc, fr, fq, c0, grow0, 0, 0, 1, 254);
    }
    template <bool SP> __device__ __forceinline__ void conv_body(const f32x4 (&acc)[2][2][4][2], int par, int wr, int wc, int fr, int fq, int c0, int grow0, int vlo, int vhi, int slo, int shi) const {
        const f32x4 zero4 = (f32x4){0.f, 0.f, 0.f, 0.f};
#pragma unroll
        for (int ai = 0; ai < 2; ++ai) { const int blk = ai * 2 + wr;
            v2u keep[4];
            const int bp = blk > 0 ? blk - 1 : 0, bn = blk < 3 ? blk + 1 : 3;
            const int tb = blk * 64 + 4 * fr;
            bf16* outp = ACT + ((long)grow0 + tb) * DFF + c0;
#pragma unroll
            for (int n = 0; n < 2; ++n) {
                f32x4 w0[2], w1[2], w2[2], bq[2], up[2], dn[2], a[2][4];
#pragma unroll
                for (int bj = 0; bj < 2; ++bj) { const PG8_LAS float* wl = WB + par * 1024 + bj * 512 + wc * 32 + 8 * fq + 4 * n;
                    w0[bj] = *(const PG8_LAS f32x4*)(wl); w1[bj] = *(const PG8_LAS f32x4*)(wl + 128); w2[bj] = *(const PG8_LAS f32x4*)(wl + 256); bq[bj] = *(const PG8_LAS f32x4*)(wl + 384);
                    const f32x4 pe = *(const PG8_LAS f32x4*)(EX + ((bp * 4 + wc) * 2 + 1) * 64 + fq * 16 + bj * 8 + 4 * n);
                    const f32x4 ne = *(const PG8_LAS f32x4*)(EX + ((bn * 4 + wc) * 2 + 0) * 64 + fq * 16 + bj * 8 + 4 * n);
#pragma unroll
                    for (int mm = 0; mm < 4; ++mm) { a[bj][mm] = acc[ai][bj][mm][n]; if (SP) { if (tb + mm < vlo || tb + mm > vhi) a[bj][mm] = zero4; } }
#pragma unroll
                    for (int i = 0; i < 4; ++i) { up[bj][i] = dpp_mov<0x111>(pe[i], a[bj][3][i]); dn[bj][i] = dpp_mov<0x101>(ne[i], a[bj][0][i]); }
                    if (SP) { if (tb - 1 < vlo || tb - 1 > vhi) up[bj] = zero4; if (tb + 4 < vlo || tb + 4 > vhi) dn[bj] = zero4; } }
#pragma unroll
                for (int m = 0; m < 4; ++m) {
                    const f32x4 gm = m == 0 ? up[0] : a[0][m > 0 ? m - 1 : 0], gp = m == 3 ? dn[0] : a[0][m < 3 ? m + 1 : 3];
                    const f32x4 vm = m == 0 ? up[1] : a[1][m > 0 ? m - 1 : 0], vp = m == 3 ? dn[1] : a[1][m < 3 ? m + 1 : 3];
                    const f32x4 yg = bq[0] + w0[0] * gm + w1[0] * a[0][m] + w2[0] * gp;
                    const f32x4 yv = bq[1] + w0[1] * vm + w1[1] * a[1][m] + w2[1] * vp;
                    const f32x4 t = yg * -1.4426950408889634f; f32x4 e;
#pragma unroll
                    for (int i = 0; i < 4; ++i) e[i] = __builtin_amdgcn_exp2f(t[i]);
                    const f32x4 d = e + 1.0f; f32x4 r;
#pragma unroll
                    for (int i = 0; i < 4; ++i) r[i] = __builtin_amdgcn_rcpf(d[i]);
                    const f32x4 o = (yg * yv) * r;
                    v2u w; w.x = pg8::cvt_pk_bf16(o[0], o[1]); w.y = pg8::cvt_pk_bf16(o[2], o[3]);
                    if (n == 0) keep[m] = w;
                    else if (tb + m >= slo && tb + m <= shi) *(v4u*)(outp + (long)m * DFF) = (v4u){keep[m].x, keep[m].y, w.x, w.y}; }
            }
        }
    }
};
struct EpiResid {
    static constexpr bool PERM = true;
    bf16* X; const float* gt_lat; const float* gt_ctx; float* PART; const float* Xin32; const bf16* Xin16;
    __device__ __forceinline__ void operator()(const f32x4 (&acc)[2][2][4][2], const Unit& u, int wr, int wc, int fr, int fq) const {
        const float* gt = (u.pm >= 32) ? gt_ctx : gt_lat;
        const int col0 = u.pn * 256 + wc * 32 + 8 * fq;
        if (u.ks >= 0) {
#pragma unroll
            for (int ai = 0; ai < 2; ++ai)
#pragma unroll
                for (int m = 0; m < 4; ++m) { bf16* p = (bf16*)PART + ((size_t)u.ks * 256 + ai * 128 + wr * 64 + m * 16 + fr) * D + col0;
#pragma unroll
                    for (int bj = 0; bj < 2; ++bj) { const f32x4 a = acc[ai][bj][m][0], b = acc[ai][bj][m][1];
                        *(v4u*)(p + bj * 128) = (v4u){pk2(a[0], a[1]), pk2(a[2], a[3]), pk2(b[0], b[1]), pk2(b[2], b[3])}; } }
            return;
        }
        f32x4 gv[2][2];
#pragma unroll
        for (int bj = 0; bj < 2; ++bj)
#pragma unroll
            for (int n = 0; n < 2; ++n) gv[bj][n] = *(const f32x4*)(gt + col0 + bj * 128 + n * 4);
        if (Xin32) {
#pragma unroll
            for (int ai = 0; ai < 2; ++ai) {
                f32x4 xv[4][2][2];
#pragma unroll
                for (int m = 0; m < 4; ++m) { const float* p = Xin32 + (size_t)(u.pm * 256 + ai * 128 + wr * 64 + m * 16 + fr) * D + col0;
#pragma unroll
                    for (int bj = 0; bj < 2; ++bj)
#pragma unroll
                        for (int n = 0; n < 2; ++n) xv[m][bj][n] = *(const f32x4*)(p + bj * 128 + n * 4); }
#pragma unroll
                for (int m = 0; m < 4; ++m) { bf16* p = X + (size_t)(u.pm * 256 + ai * 128 + wr * 64 + m * 16 + fr) * D + col0;
#pragma unroll
                    for (int bj = 0; bj < 2; ++bj) { const f32x4 a = xv[m][bj][0] + gv[bj][0] * acc[ai][bj][m][0], b = xv[m][bj][1] + gv[bj][1] * acc[ai][bj][m][1];
                        *(v4u*)(p + bj * 128) = (v4u){pk2(a[0], a[1]), pk2(a[2], a[3]), pk2(b[0], b[1]), pk2(b[2], b[3])}; } }
            }
        } else {
#pragma unroll
            for (int ai = 0; ai < 2; ++ai) {
                v4u xv[4][2];
#pragma unroll
                for (int m = 0; m < 4; ++m) { const bf16* p = Xin16 + (size_t)(u.pm * 256 + ai * 128 + wr * 64 + m * 16 + fr) * D + col0;
#pragma unroll
                    for (int bj = 0; bj < 2; ++bj) xv[m][bj] = *(const v4u*)(p + bj * 128); }
#pragma unroll
                for (int m = 0; m < 4; ++m) { bf16* p = X + (size_t)(u.pm * 256 + ai * 128 + wr * 64 + m * 16 + fr) * D + col0;
#pragma unroll
                    for (int bj = 0; bj < 2; ++bj) { const v4u x = xv[m][bj];
                        const f32x4 a = (f32x4){bflo(x.x), bfhi(x.x), bflo(x.y), bfhi(x.y)} + gv[bj][0] * acc[ai][bj][m][0], b = (f32x4){bflo(x.z), bfhi(x.z), bflo(x.w), bfhi(x.w)} + gv[bj][1] * acc[ai][bj][m][1];
                        *(v4u*)(p + bj * 128) = (v4u){pk2(a[0], a[1]), pk2(a[2], a[3]), pk2(b[0], b[1]), pk2(b[2], b[3])}; } }
            }
        }
    }
};
struct EpiRope {
    static constexpr bool PERM = false;
    bf16 *F, *Q, *KB, *VB; const float* ropec; const float* ropes;
    __device__ __forceinline__ void operator()(const f32x4 (&acc)[2][2][4][2], const Unit& u, int wr, int wc, int fr, int fq) const {
        const bool lat = u.pm < 32;
        f32x4 csv[2][4], snv[2][4];
#pragma unroll
        for (int ai = 0; ai < 2; ++ai)
#pragma unroll
            for (int m = 0; m < 4; ++m) {
                const int row = u.pm * 256 + ai * 128 + wr * 64 + m * 16 + fr;
                const int pos = (wc & 1) ? (row & 63) : ((row >> 6) & 127);
                csv[ai][m] = (f32x4){1.f, 1.f, 1.f, 1.f}; snv[ai][m] = (f32x4){0.f, 0.f, 0.f, 0.f};
                if (lat && u.pn >= 4) { csv[ai][m] = *(const f32x4*)(ropec + pos * 16 + 4 * fq); snv[ai][m] = *(const f32x4*)(ropes + pos * 16 + 4 * fq); }
            }
#pragma unroll
        for (int ai = 0; ai < 2; ++ai)
#pragma unroll
            for (int m = 0; m < 4; ++m) {
                const int row = u.pm * 256 + ai * 128 + wr * 64 + m * 16 + fr;
                const f32x4 cs = csv[ai][m], sn = snv[ai][m];
#pragma unroll
                for (int bj = 0; bj < 2; ++bj) {
                    const int c0 = u.pn * 256 + bj * 128 + wc * 32;
                    f32x4 x1 = acc[ai][bj][m][0], x2 = acc[ai][bj][m][1];
                    bf16* dst; int ld;
                    if (c0 < 1024) { dst = F + (size_t)row * 1024 + c0; ld = 0; }
                    else if (c0 < 2048) { dst = Q + (size_t)row * 1024 + (c0 - 1024); ld = 1; }
                    else if (c0 < 2176) { dst = KB + (size_t)row * 128 + (c0 - 2048); ld = 2; }
                    else { dst = VB + (size_t)row * 128 + (c0 - 2176); ld = 3; }
                    if (ld == 1 || ld == 2) {
                        const f32x4 y1 = x1 * cs - x2 * sn, y2 = x1 * sn + x2 * cs;
                        x1 = y1; x2 = y2;
                        if (ld == 1) { x1 = x1 * (0.125f * LOG2E); x2 = x2 * (0.125f * LOG2E); }
                    }
                    v2u w1, w2; w1.x = pg8::cvt_pk_bf16(x1[0], x1[1]); w1.y = pg8::cvt_pk_bf16(x1[2], x1[3]); w2.x = pg8::cvt_pk_bf16(x2[0], x2[1]); w2.y = pg8::cvt_pk_bf16(x2[2], x2[3]);
                    *(v2u*)(dst + 4 * fq) = w1; *(v2u*)(dst + 16 + 4 * fq) = w2;
                }
            }
    }
};
struct EpiGates {
    static constexpr bool PERM = true;
    const float *b_a, *b_i, *lam;
    const bf16* XSC; unsigned* LG;
    __device__ __forceinline__ void operator()(const f32x4 (&acc)[2][2][4][2], const Unit& u, int wr, int wc, int fr, int fq) const {
        const int d = u.pn >> 1, half = u.pn & 1;
        const int col0 = u.pb * 256 + half * 128 + wc * 32 + 8 * fq;
        v2u xwv[2][2][4];
#pragma unroll
        for (int n = 0; n < 2; ++n)
#pragma unroll
            for (int ai = 0; ai < 2; ++ai)
#pragma unroll
                for (int m = 0; m < 4; ++m) xwv[n][ai][m] = *(const v2u*)(XSC + (size_t)(u.pm * 256 + ai * 128 + wr * 64 + m * 16 + fr) * D + col0 + n * 4);
        f32x4 bav[2], biv[2], spv[2];
#pragma unroll
        for (int n = 0; n < 2; ++n) { bav[n] = *(const f32x4*)(b_a + d * D + col0 + n * 4); biv[n] = *(const f32x4*)(b_i + d * D + col0 + n * 4); spv[n] = *(const f32x4*)(lam + d * D + col0 + n * 4); }
#pragma unroll
        for (int n = 0; n < 2; ++n) {
            const f32x4 ba = bav[n], bi = biv[n];
            const f32x4 sp = spv[n] * 1.4426950408889634f;
#pragma unroll
            for (int ai = 0; ai < 2; ++ai)
#pragma unroll
                for (int m = 0; m < 4; ++m) { const int row = u.pm * 256 + ai * 128 + wr * 64 + m * 16 + fr;
                    const v2u xw = xwv[n][ai][m];
                    const f32x4 xs = (f32x4){bflo(xw.x), bfhi(xw.x), bflo(xw.y), bfhi(xw.y)};
                    const f32x4 ta = (acc[ai][0][m][n] + ba) * -1.4426950408889634f, ti = (acc[ai][1][m][n] + bi) * -1.4426950408889634f;
                    f32x4 ea, ei;
#pragma unroll
                    for (int i = 0; i < 4; ++i) { ea[i] = __builtin_amdgcn_exp2f(ta[i]); ei[i] = __builtin_amdgcn_exp2f(ti[i]); }
                    const f32x4 da = ea + 1.0f, di = ei + 1.0f, dd = da * di; f32x4 inv;
#pragma unroll
                    for (int i = 0; i < 4; ++i) inv[i] = __builtin_amdgcn_rcpf(dd[i]);
                    const f32x4 l2 = (di * inv) * sp;
                    f32x4 av;
#pragma unroll
                    for (int i = 0; i < 4; ++i) av[i] = __builtin_amdgcn_exp2f(l2[i]);
                    const f32x4 q = 1.0f - av;
                    const f32x4 om = q * (2.0f - q);
                    f32x4 sq;
#pragma unroll
                    for (int i = 0; i < 4; ++i) sq[i] = __builtin_amdgcn_sqrtf(om[i]);
                    const f32x4 gx = sq * ((da * inv) * xs);
                    v4u lg;
#pragma unroll
                    for (int i = 0; i < 4; ++i) lg[i] = pg8::cvt_pk_bf16(q[i], gx[i]);
                    const size_t o = ((size_t)d * MT + row) * D + col0 + n * 4;
                    *(v4u*)(LG + o) = lg;
                }
        }
    }
};

struct Args { const float* in[25]; float* out; unsigned char* ws; int ph_lo, ph_hi; };
enum { I_X = 0, I_C, I_CTX, I_CCTX, I_WMOD, I_BMOD, I_GMIX, I_GFFN, I_FAWIN, I_FAWOUT, I_SINK, I_RGWIN, I_RGCW, I_RGCB, I_RGWA, I_RGBA, I_RGWI, I_RGBI, I_RGLAM, I_RGWOUT, I_WUP, I_FCW, I_FCB, I_WDOWN, I_GFINAL };

__device__ __forceinline__ const float* inp(LAS unsigned char* lds, int i) {
    unsigned off = PTAB_OFF; asm volatile("" : "+s"(off));
    const volatile LAS unsigned* p = (const volatile LAS unsigned*)(lds + off) + 2 * i;
    const unsigned lo = __builtin_amdgcn_readfirstlane(p[0]), hi = __builtin_amdgcn_readfirstlane(p[1]);
    return (const float*)(GAS const float*)(((unsigned long long)hi << 32) | lo);
}
__device__ __forceinline__ unsigned char* opaque(unsigned char* p) { GAS unsigned char* q = (GAS unsigned char*)p; asm volatile("" : "+s"(q)); return (unsigned char*)q; }
struct TrItem { const float* W; bf16* WT; int ldw, k0, n0, Kdst, drow0, drow1; };
__device__ __forceinline__ void tr_load(const TrItem& d, float (&t)[64], int lane) {
    const float* Wp = d.W + (size_t)d.k0 * d.ldw + d.n0 + lane;
#pragma unroll
    for (int i = 0; i < 64; ++i) t[i] = __builtin_nontemporal_load(Wp + (size_t)i * d.ldw);
}
__device__ __forceinline__ void tr_store(const TrItem& d, const float (&t)[64], LAS unsigned* scr, int lane) {
#pragma unroll
    for (int i = 0; i < 32; ++i) scr[i * 65 + lane] = pk2(t[2 * i], t[2 * i + 1]);
    asm volatile("s_waitcnt lgkmcnt(0)" ::: "memory");
    const int c = lane & 7;
#pragma unroll
    for (int j = 0; j < 8; ++j) { const int n = (lane >> 3) + 8 * j; const LAS unsigned* sp = scr + (4 * c) * 65 + n;
        const v4u o = (v4u){sp[0], sp[65], sp[130], sp[195]};
        const int drow = n < 32 ? d.drow0 + n : d.drow1 + (n - 32);
        *(v4u*)(d.WT + (size_t)drow * d.Kdst + d.k0 + 8 * c) = o; }
    asm volatile("s_waitcnt lgkmcnt(0)" ::: "memory");
}

constexpr int BG0_PRO = 30;
constexpr int NI_FA = 32 * 36 + 32 * 32, NI_RG = 32 * 64 + 32 * 32 + 2 * 2 * 8 * 4 * 4, NI_UP = 32 * 176, NI_DN = 88 * 32, MODKS = 32, NI_MOD = 48 * MODKS;
__device__ __forceinline__ int layer_items(int L) { return ((L & 1) ? NI_RG : NI_FA) + NI_UP + NI_DN; }
__device__ __forceinline__ TrItem layer_item(unsigned char* ws, LAS unsigned char* lds, int L, int r) {
    const int l = L >> 1; TrItem d;
    if ((L & 1) == 0) {
        if (r < 32 * 36) { const int kb = r / 36, nb = r % 36; d = TrItem{inp(lds, I_FAWIN) + (size_t)l * D * FA_IN, (bf16*)(ws + WS_WINFA) + (size_t)l * FA_IN * D, FA_IN, kb * 64, nb * 64, D, nb * 64, nb * 64 + 32}; return d; } r -= 32 * 36;
        if (r < 32 * 32) { const int kb = r / 32, nb = r % 32; d = TrItem{inp(lds, I_FAWOUT) + (size_t)l * D * D, (bf16*)(ws + WS_WOUTFA) + (size_t)l * D * D, D, kb * 64, nb * 64, D, nb * 64, nb * 64 + 32}; return d; } r -= 32 * 32;
    } else {
        if (r < 32 * 64) { const int kb = r / 64, nb = r % 64; d = TrItem{inp(lds, I_RGWIN) + (size_t)l * D * 4096, (bf16*)(ws + WS_WINRG) + (size_t)l * 4096 * D, 4096, kb * 64, nb * 64, D, nb * 64, nb * 64 + 32}; return d; } r -= 32 * 64;
        if (r < 32 * 32) { const int kb = r / 32, nb = r % 32; d = TrItem{inp(lds, I_RGWOUT) + (size_t)l * D * D, (bf16*)(ws + WS_WOUTRG) + (size_t)l * D * D, D, kb * 64, nb * 64, D, nb * 64, nb * 64 + 32}; return d; } r -= 32 * 32;
        if (r < 512) {
            const int nb = r & 3, kb = (r >> 2) & 3, h = (r >> 4) & 7, dd = (r >> 7) & 1, ai = (r >> 8) & 1;
            const int n0 = nb * 64; const int drow = h * 1024 + (dd * 2 + (n0 >> 7)) * 256 + ai * 128 + (n0 & 127);
            d = TrItem{inp(lds, ai ? I_RGWI : I_RGWA) + ((size_t)((l * 2 + dd) * 8 + h)) * 256 * 256, (bf16*)(ws + WS_WGATE) + (size_t)l * 8 * 1024 * 256, 256, kb * 64, n0, 256, drow, drow + 32}; return d; } r -= 512;
    }
    if (r < NI_UP) { const int kb = r / 176, nb = r % 176;
        const int n0 = nb * 64, isv = n0 >= DFF, nn = isv ? n0 - DFF : n0;
        const int dr = (nn >> 7) * 256 + isv * 128 + (nn & 127);
        d = TrItem{inp(lds, I_WUP) + (size_t)L * D * DFF2, (bf16*)(ws + WS_WUP) + (size_t)L * DFF2 * D, DFF2, kb * 64, n0, D, dr, dr + 32}; return d; } r -= NI_UP;
    { const int kb = r / 32, nb = r % 32; d = TrItem{inp(lds, I_WDOWN) + (size_t)L * DFF * D, (bf16*)(ws + WS_WDOWN) + (size_t)L * D * DFF, D, kb * 64, nb * 64, DFF, nb * 64, nb * 64 + 32}; }
    return d;
}
__device__ __forceinline__ void run_layer_items(unsigned char* ws, LAS unsigned char* lds, int L, int it0, int stride, int tot, LAS unsigned* scr, int lane) {
    if (it0 >= tot) return;
    float ta[64], tb[64];
    TrItem da = layer_item(ws, lds, L, it0); tr_load(da, ta, lane);
    for (int it = it0; it < tot; it += stride) {
        const bool more = it + stride < tot; TrItem db = da;
        if (more) { db = layer_item(ws, lds, L, it + stride); tr_load(db, tb, lane); }
        tr_store(da, ta, scr, lane);
        if (more) { da = db;
#pragma unroll
            for (int i = 0; i < 64; ++i) ta[i] = tb[i]; }
    }
}
__device__ __forceinline__ void mod_item(unsigned char* ws, LAS unsigned char* lds, int L, int it, int lane) {
    constexpr int RK = D / MODKS;
    const int ks = it % MODKS, cg = it / MODKS;
    const float* W = inp(lds, I_WMOD) + (size_t)L * D * NMOD6 + (size_t)(ks * RK) * NMOD6 + cg * 256 + lane * 4;
    const float* cl = inp(lds, I_C) + ks * RK; const float* cc = inp(lds, I_CCTX) + ks * RK;
    f32x4 al = (f32x4){0.f, 0.f, 0.f, 0.f}, ac = al;
    for (int k = 0; k < RK; k += 16) {
        f32x4 w[16];
#pragma unroll
        for (int j = 0; j < 16; ++j) w[j] = __builtin_nontemporal_load((const f32x4*)(W + (size_t)(k + j) * NMOD6));
#pragma unroll
        for (int j = 0; j < 16; ++j) { const float s0 = siluf_(cl[k + j]), s1 = siluf_(cc[k + j]); al += w[j] * s0; ac += w[j] * s1; }
    }
    if (ks == 0) { const f32x4 b = *(const f32x4*)(inp(lds, I_BMOD) + (size_t)L * NMOD6 + cg * 256 + lane * 4); al += b; ac += b; }
    float* o = (float*)(ws + WS_MODP) + ((size_t)(ks * 4 + L) * 2) * NMOD6 + cg * 256 + lane * 4;
    *(f32x4*)o = al; *(f32x4*)(o + NMOD6) = ac;
}
__device__ __forceinline__ void mod_final(unsigned char* ws, int L, int bid, int G, int wv) {
    if (L >= DEPTH) return;
    const int tid = otid(wv); const int gtid = bid * NTHR + tid, NGT = G * NTHR;
    const float* part = (const float*)(ws + WS_MODP); float* mod = (float*)(ws + WS_MOD);
    for (int e = gtid; e < 2 * NMOD6; e += NGT) { const int ee = L * 2 * NMOD6 + e; float sacc = 0.f;
#pragma unroll
        for (int ks = 0; ks < MODKS; ++ks) sacc += part[(size_t)ks * 4 * 2 * NMOD6 + ee];
        mod[ee] = sacc; }
}
__device__ __forceinline__ void bg_run(unsigned char* ws, LAS unsigned char* lds, int tgt, int first_idle, int pctA, int pctB, int bid, int G, int wv) {
    if (tgt >= DEPTH) return;
    const int tid = otid(wv), lane = tid & 63;
    LAS unsigned* scr = (LAS unsigned*)(lds + wv * 8448);
    const int tot = layer_items(tgt), nA = (tot * pctA / 100);
    if (bid >= first_idle) {
        const int giw = (bid - first_idle) * NWAVES + wv, nw = (G - first_idle) * NWAVES;
        for (int it = giw; it < NI_MOD; it += nw) mod_item(ws, lds, tgt, it, lane);
        run_layer_items(ws, lds, tgt, (giw + nw - NI_MOD % nw) % nw, nw, nA, scr, lane);
    }
    run_layer_items(ws, lds, tgt, nA + bid * NWAVES + wv, G * NWAVES, tot * pctB / 100, scr, lane);
}
__device__ __forceinline__ void bg_part(unsigned char* ws, LAS unsigned char* lds, int tgt, int nunits, int p0, int p1, int bid, int G, int wv) {
    const int first_idle = nunits - ((nunits - 1) / G) * G;
    if (tgt >= DEPTH || bid < first_idle) return;
    const int tid = otid(wv), lane = tid & 63;
    LAS unsigned* scr = (LAS unsigned*)(lds + wv * 8448);
    const int tot = layer_items(tgt);
    run_layer_items(ws, lds, tgt, tot * p0 / 100 + (bid - first_idle) * NWAVES + wv, (G - first_idle) * NWAVES, tot * p1 / 100, scr, lane);
}

__device__ __forceinline__ void bg_slot(unsigned char* ws, LAS unsigned char* lds, int tgt, int idx, int nidle, bool withmod, int p0, int p1, int wv) {
    if (tgt >= DEPTH || idx < 0) return;
    const int tid = otid(wv), lane = tid & 63;
    LAS unsigned* scr = (LAS unsigned*)(lds + wv * 8448);
    const int giw = idx * NWAVES + wv, nw = nidle * NWAVES; int skew = 0;
    if (withmod) { for (int it = giw; it < NI_MOD; it += nw) mod_item(ws, lds, tgt, it, lane); skew = NI_MOD % nw; }
    const int tot = layer_items(tgt);
    run_layer_items(ws, lds, tgt, tot * p0 / 100 + (giw + nw - skew) % nw, nw, tot * p1 / 100, scr, lane);
}
__device__ __forceinline__ int tail_first(int nunits, int G) { return nunits - ((nunits - 1) / G) * G; }

__device__ __forceinline__ void phase_prologue(unsigned char* ws, LAS unsigned char* lds, int bid, int G, int wv) {
    const int tid = otid(wv), lane = tid & 63, wave = wv; const int gw = bid * NWAVES + wave, NGW = G * NWAVES, gtid = bid * NTHR + tid, NGT = G * NTHR; (void)lane; (void)gw; (void)NGW; (void)gtid; (void)NGT;
    LAS unsigned* scr = (LAS unsigned*)(lds + wave * 8448);
    for (int it = gw; it < NI_MOD; it += NGW) mod_item(ws, lds, 0, it, lane);
    run_layer_items(ws, lds, 0, (gw + NGW - NI_MOD % NGW) % NGW, NGW, layer_items(0) * BG0_PRO / 100, scr, lane);
    {
        bf16* DA = (bf16*)(ws + WS_DA);
        for (int e = gtid; e < 256 * 256; e += NGT) { const int r = e >> 8, cc = e & 255, c = r >> 7, k1 = r & 127, cp = cc >> 7, n1 = cc & 127; const int ph = (k1 * n1) & 127; float sv, cv; sincospif((float)ph * (1.0f / 64.0f), &sv, &cv);
            const float v = (c == 0) ? (cp == 0 ? cv : -sv) : (cp == 0 ? -sv : -cv); DA[e] = (bf16)f2bf(v); }
        bf16* DB = (bf16*)(ws + WS_DB4);
        for (int e = gtid; e < 256 * 512; e += NGT) { const int r = e >> 9, cc = e & 511, pp = r >> 6, k2 = r & 63, p = cc >> 7, c = (cc >> 6) & 1, n2 = cc & 63; const int ph = (k2 * n2) & 63; float sv, cv; sincospif((float)ph * (1.0f / 32.0f), &sv, &cv);
            DB[e] = (bf16)f2bf(p == pp ? (c ? sv : cv) : 0.0f); }
        float* twc = (float*)(ws + WS_TW); float* tws = twc + 128 * 64;
        for (int e = gtid; e < 128 * 64; e += NGT) { const int k1 = e >> 6, n2 = e & 63; float sv, cv; sincospif((float)(k1 * n2) * (1.0f / 4096.0f), &sv, &cv); twc[e] = cv; tws[e] = sv; }
        bf16* C = (bf16*)(ws + WS_DFTC);
        for (int e = gtid; e < 512 * 256; e += NGT) { const int mp = e >> 8, c = e & 255, m = mp >> 1, s = mp & 1; const int ph = (m * c) & 255; float sv, cv; sincospif((float)ph * (1.0f / 128.0f), &sv, &cv); C[e] = (bf16)f2bf(s ? sv : cv); }
        bf16* N = (bf16*)(ws + WS_DFTNC);
        for (int e = gtid; e < 256 * 512; e += NGT) { const int k = e >> 9, cc = e & 511, s = cc >> 8, n = cc & 255; const int ph = (k * n) & 255; float sv, cv; sincospif((float)ph * (1.0f / 128.0f), &sv, &cv); N[e] = (bf16)f2bf(s ? -sv : cv); }
        float* rc = (float*)(ws + WS_ROPE); float* rs = rc + 128 * 16;
        { const float* lam = inp(lds, I_RGLAM); float* sp8 = (float*)(ws + WS_SP8); for (int e = gtid; e < 2 * 2 * D; e += NGT) { const float z = -lam[e]; sp8[e] = -8.0f * (fmaxf(z, 0.f) + log1pf(expf(-fabsf(z)))); } }
        for (int e = gtid; e < 128 * 16; e += NGT) { const int pos = e >> 4, f = e & 15; const float inv = powf(10000.0f, -(float)f / 16.0f); const float ang = (float)pos * inv; rc[e] = cosf(ang); rs[e] = sinf(ang); }
    }
}
__device__ __forceinline__ void phase_norm(const float* XL32, const float* XC32, bf16* X, bf16* H, const float* g, const float* mod_lat, const float* mod_ctx, int ish, int isc, LAS unsigned char* lds, int nrows, const float* PART, int nsl, const float* gtc, int bid, int G, int wv) {
    const int tid = otid(wv), lane = tid & 63, wave = wv; const int gw = bid * NWAVES + wave, NGW = G * NWAVES;
    LAS float* T = (LAS float*)lds;
    v2u nr[8]; bool have = false;
    if (gw < nrows && !(gw < SEQ ? XL32 != nullptr : XC32 != nullptr)) { const v2u* p = (const v2u*)(X + (size_t)gw * D) + lane;
#pragma unroll
        for (int j = 0; j < 8; ++j) nr[j] = p[64 * j];
        have = true; }
    {   static_assert(D == 4 * NTHR, "one f32x4 of each table vector per thread");
        const int i4 = tid * 4;
        const f32x4 gg = *(const f32x4*)(g + i4), lsc = *(const f32x4*)(mod_lat + isc * D + i4), lsh = *(const f32x4*)(mod_lat + ish * D + i4), csc = *(const f32x4*)(mod_ctx + isc * D + i4), csh = *(const f32x4*)(mod_ctx + ish * D + i4);
        *(LAS f32x4*)(T + i4) = gg * (lsc + 1.0f); *(LAS f32x4*)(T + D + i4) = lsh; *(LAS f32x4*)(T + 2 * D + i4) = gg * (csc + 1.0f); *(LAS f32x4*)(T + 3 * D + i4) = csh; }
    __syncthreads();
    for (int m = gw; m < nrows; m += NGW) {
        const float* src32 = m < SEQ ? (XL32 ? XL32 + (size_t)m * D : nullptr) : (XC32 ? XC32 + (size_t)(m - SEQ) * D : nullptr);
        v2u* xr = (v2u*)(X + (size_t)m * D) + lane;
        f32x4 v[8]; float s = 0.f;
        if (src32) {
#pragma unroll
            for (int j = 0; j < 8; ++j) v[j] = ((const f32x4*)src32 + lane)[64 * j];
        } else if (have) {
#pragma unroll
            for (int j = 0; j < 8; ++j) { const v2u w = nr[j]; v[j] = (f32x4){bflo(w.x), bfhi(w.x), bflo(w.y), bfhi(w.y)}; }
        } else {
#pragma unroll
            for (int j = 0; j < 8; ++j) { const v2u w = xr[64 * j]; v[j] = (f32x4){bflo(w.x), bfhi(w.x), bflo(w.y), bfhi(w.y)}; }
        }
        { const int mn = m + NGW; have = false;
          if (mn < nrows && !(mn < SEQ ? XL32 != nullptr : XC32 != nullptr)) { const v2u* p = (const v2u*)(X + (size_t)mn * D) + lane;
#pragma unroll
              for (int j = 0; j < 8; ++j) nr[j] = p[64 * j];
              have = true; } }
        if (m >= SEQ && nsl > 0) {
            f32x4 a[8];
#pragma unroll
            for (int j = 0; j < 8; ++j) a[j] = (f32x4){0.f, 0.f, 0.f, 0.f};
            for (int s0 = 0; s0 < nsl; s0 += 4) {
                v2u pw[4][8];
#pragma unroll
                for (int q = 0; q < 4; ++q) { const v2u* pr = (const v2u*)((const bf16*)PART + ((size_t)(s0 + q) * 256 + (m - SEQ)) * D) + lane;
#pragma unroll
                    for (int j = 0; j < 8; ++j) { pw[q][j] = (v2u){0u, 0u}; if (s0 + q < nsl) pw[q][j] = pr[64 * j]; } }
#pragma unroll
                for (int q = 0; q < 4; ++q)
#pragma unroll
                    for (int j = 0; j < 8; ++j) { const v2u w = pw[q][j]; a[j] += (f32x4){bflo(w.x), bfhi(w.x), bflo(w.y), bfhi(w.y)}; } }
            const f32x4* g4 = (const f32x4*)gtc + lane;
#pragma unroll
            for (int j = 0; j < 8; ++j) { v[j] += g4[64 * j] * a[j]; v2u w; w.x = pk2(v[j][0], v[j][1]); w.y = pk2(v[j][2], v[j][3]); xr[64 * j] = w;
                v[j] = (f32x4){bflo(w.x), bfhi(w.x), bflo(w.y), bfhi(w.y)}; }
        }
#pragma unroll
        for (int j = 0; j < 8; ++j) s += (v[j][0] * v[j][0] + v[j][1] * v[j][1]) + (v[j][2] * v[j][2] + v[j][3] * v[j][3]);
        const float r = 1.0f / sqrtf(wave_sum(s, lane) * (1.0f / D) + EPS);
        const LAS f32x4* G4 = (const LAS f32x4*)(T + (m >= SEQ ? 2 * D : 0)) + lane; const LAS f32x4* S4 = (const LAS f32x4*)(T + (m >= SEQ ? 3 * D : D)) + lane;
        v2u* o = (v2u*)(H + (size_t)m * D) + lane;
#pragma unroll
        for (int j = 0; j < 8; ++j) { const f32x4 gg = G4[64 * j], ss = S4[64 * j]; const f32x4 h = (v[j] * r) * gg + ss; v2u w; w.x = pk2(h[0], h[1]); w.y = pk2(h[2], h[3]); o[64 * j] = w; }
    }
    __syncthreads();
}
__device__ __forceinline__ void phase_final(const bf16* X, float* out, const float* g, int bid, int G, int wv) {
    const int tid = otid(wv), lane = tid & 63, wave = wv; const int gw = bid * NWAVES + wave, NGW = G * NWAVES, gtid = bid * NTHR + tid, NGT = G * NTHR; (void)lane; (void)gw; (void)NGW; (void)gtid; (void)NGT;
    for (int m0 = gw; m0 < SEQ; m0 += 4 * NGW) {
        v2u xw[4][8];
#pragma unroll
        for (int q = 0; q < 4; ++q) { const int m = m0 + q * NGW;
#pragma unroll
            for (int j = 0; j < 8; ++j) xw[q][j] = (v2u){0u, 0u};
            if (m < SEQ) { const v2u* xr = (const v2u*)(X + (size_t)m * D) + lane;
#pragma unroll
                for (int j = 0; j < 8; ++j) xw[q][j] = xr[64 * j]; } }
#pragma unroll
        for (int q = 0; q < 4; ++q) { const int m = m0 + q * NGW;
            if (m < SEQ) {
                f32x4 v[8]; float s = 0.f;
#pragma unroll
                for (int j = 0; j < 8; ++j) { const v2u w = xw[q][j]; v[j] = (f32x4){bflo(w.x), bfhi(w.x), bflo(w.y), bfhi(w.y)}; s += (v[j][0] * v[j][0] + v[j][1] * v[j][1]) + (v[j][2] * v[j][2] + v[j][3] * v[j][3]); }
                const float r = 1.0f / sqrtf(wave_sum(s, lane) * (1.0f / D) + EPS);
                f32x4* o = (f32x4*)(out + (size_t)m * D) + lane; const f32x4* g4 = (const f32x4*)g + lane;
#pragma unroll
                for (int j = 0; j < 8; ++j) o[64 * j] = (v[j] * r) * g4[64 * j];
            } }
    }
}
__device__ __forceinline__ void phase_conv4(const bf16* XS, bf16* XSC, bf16* GATE, const float* PART2, const float* cw, const float* cb, int bid, int G, int wv) {
    const int tid = otid(wv), lane = tid & 63, wave = wv; const int gw = bid * NWAVES + wave, NGW = G * NWAVES, gtid = bid * NTHR + tid, NGT = G * NTHR; (void)lane; (void)gw; (void)NGW; (void)gtid; (void)NGT;
    const int cg = gtid & 255, r0 = gtid >> 8, rstep = NGT >> 8;
    float w[4][8], b[8];
#pragma unroll
    for (int i = 0; i < 8; ++i) { b[i] = cb[cg * 8 + i];
#pragma unroll
        for (int k = 0; k < 4; ++k) w[k][i] = cw[k * D + cg * 8 + i]; }
    {
        const int c16 = gtid >> 8;
        for (int ch = c16; ch < SEQ / 16; ch += rstep) {
            int t0 = ch * 16; asm volatile("" : "+v"(t0));
            v4u x[19];
#pragma unroll
            for (int j = 0; j < 19; ++j) { const int tt = t0 + j - 2; x[j] = (v4u){0u, 0u, 0u, 0u}; if (tt >= 0 && tt < SEQ) x[j] = *(const v4u*)(XS + (unsigned)(tt * D + cg * 8)); }
#pragma unroll
            for (int r = 0; r < 16; ++r) {
                float y[8];
#pragma unroll
                for (int i = 0; i < 8; ++i) y[i] = b[i];
#pragma unroll
                for (int k = 0; k < 4; ++k) { const v4u xx = x[r + k];
                    y[0] += w[k][0] * bflo(xx.x); y[1] += w[k][1] * bfhi(xx.x); y[2] += w[k][2] * bflo(xx.y); y[3] += w[k][3] * bfhi(xx.y);
                    y[4] += w[k][4] * bflo(xx.z); y[5] += w[k][5] * bfhi(xx.z); y[6] += w[k][6] * bflo(xx.w); y[7] += w[k][7] * bfhi(xx.w); }
                *(v4u*)(XSC + (unsigned)((t0 + r) * D + cg * 8)) = (v4u){pk2(y[0], y[1]), pk2(y[2], y[3]), pk2(y[4], y[5]), pk2(y[6], y[7])};
            }
        }
    }
    for (int it = gtid; it < CTXL * 256; it += NGT) {
        const int t = SEQ + (it >> 8);
        float y[8];
#pragma unroll
        for (int i = 0; i < 8; ++i) y[i] = b[i];
        {
#pragma unroll
            for (int k = 0; k < 4; ++k) { const int tt = t + k - 2; if (tt >= SEQ && tt < MT) { f32x4 a0 = (f32x4){0.f, 0.f, 0.f, 0.f}, a1 = a0;
#pragma unroll
                    for (int sl = 0; sl < 2; ++sl) { const float* p = PART2 + ((size_t)sl * 256 + (tt - SEQ)) * 4096 + D + cg * 8; a0 += *(const f32x4*)p; a1 += *(const f32x4*)(p + 4); }
#pragma unroll
                    for (int i = 0; i < 4; ++i) { y[i] += w[k][i] * a0[i]; y[4 + i] += w[k][4 + i] * a1[i]; } } }
            f32x4 g0 = (f32x4){0.f, 0.f, 0.f, 0.f}, g1 = g0;
#pragma unroll
            for (int sl = 0; sl < 2; ++sl) { const float* p = PART2 + ((size_t)sl * 256 + (t - SEQ)) * 4096 + cg * 8; g0 += *(const f32x4*)p; g1 += *(const f32x4*)(p + 4); }
            *(v4u*)(GATE + (size_t)t * D + cg * 8) = (v4u){pk2(g0[0], g0[1]), pk2(g0[2], g0[3]), pk2(g1[0], g1[1]), pk2(g1[2], g1[3])};
            *(v4u*)(XSC + (size_t)t * D + cg * 8) = (v4u){pk2(y[0], y[1]), pk2(y[2], y[3]), pk2(y[4], y[5]), pk2(y[6], y[7])};
        }
    }
}
__device__ __forceinline__ void phase_conv3_ctx(const bf16* U, bf16* ACT, const float* cw, const float* cb, int bid, int G, int wv) {
    const int tid = otid(wv); const int gtid = bid * NTHR + tid, NGT = G * NTHR;
    constexpr int NCG = DFF / 8;
    for (int it = gtid; it < CTXL * NCG; it += NGT) {
        const int cg = it % NCG, t = SEQ + it / NCG, c0 = cg * 8, uc = (c0 >> 7) * 256 + (c0 & 127);
        float yg[8], yv[8];
#pragma unroll
        for (int i = 0; i < 8; ++i) { yg[i] = cb[c0 + i]; yv[i] = cb[DFF + c0 + i]; }
#pragma unroll
        for (int k = 0; k < 3; ++k) { const int tt = t + k - 1; if (tt >= SEQ && tt < MT) {
                const v4u x = *(const v4u*)(U + (size_t)tt * DFF2 + uc); const v4u z = *(const v4u*)(U + (size_t)tt * DFF2 + uc + 128);
                const float xg[8] = {bflo(x.x), bfhi(x.x), bflo(x.y), bfhi(x.y), bflo(x.z), bfhi(x.z), bflo(x.w), bfhi(x.w)}, xv[8] = {bflo(z.x), bfhi(z.x), bflo(z.y), bfhi(z.y), bflo(z.z), bfhi(z.z), bflo(z.w), bfhi(z.w)};
#pragma unroll
                for (int i = 0; i < 8; ++i) { yg[i] += cw[k * DFF2 + c0 + i] * xg[i]; yv[i] += cw[k * DFF2 + DFF + c0 + i] * xv[i]; } } }
        float o[8];
#pragma unroll
        for (int i = 0; i < 8; ++i) o[i] = siluf_(yg[i]) * yv[i];
        *(v4u*)(ACT + (size_t)t * DFF + c0) = (v4u){pk2(o[0], o[1]), pk2(o[2], o[3]), pk2(o[4], o[5]), pk2(o[6], o[7])};
    }
}
constexpr int NSEG = MT / 64;
template <int ST, int NSTEP> __device__ __forceinline__ void scan_col_sum(const LAS unsigned* T, float& h, float& ap) {
#pragma unroll
    for (int j0 = 0; j0 < NSTEP; j0 += 16) { unsigned w[16];
#pragma unroll
        for (int k = 0; k < 16; ++k) w[k] = (j0 + k < NSTEP) ? T[(j0 + k) * ST] : 0u;
#pragma unroll
        for (int k = 0; k < 16; ++k) if (j0 + k < NSTEP) { const float a = 1.0f - bflo(w[k]); h = a * h + bfhi(w[k]); ap *= a; } }
}
template <int ST> __device__ __forceinline__ void scan_col_apply(LAS unsigned* T, float h) {
#pragma unroll
    for (int j0 = 0; j0 < 64; j0 += 16) { unsigned w[16];
#pragma unroll
        for (int k = 0; k < 16; ++k) w[k] = T[(j0 + k) * ST];
#pragma unroll
        for (int k = 0; k < 16; ++k) { h = (1.0f - bflo(w[k])) * h + bfhi(w[k]); w[k] = __builtin_bit_cast(unsigned, h); }
#pragma unroll
        for (int k = 0; k < 16; ++k) T[(j0 + k) * ST] = w[k]; }
}
__device__ __forceinline__ void scan_fetch(v4u (&rg)[8], const unsigned* LG, int item, int tid) {
    const int row0 = (item >> 4) * 64, col0 = (item & 15) * 128;
#pragma unroll
    for (int i = 0; i < 8; ++i) { const int p = tid + i * NTHR, d = p >> 11, r = (p >> 5) & 63, c4 = p & 31; rg[i] = *(const v4u*)(LG + ((size_t)d * MT + row0 + r) * D + col0 + c4 * 4); }
}
__device__ __forceinline__ void scan_stash(LAS unsigned char* lds, const v4u (&rg)[8], int tid) {
#pragma unroll
    for (int i = 0; i < 8; ++i) *(LAS v4u*)(lds + (size_t)(tid + i * NTHR) * 16) = rg[i];
}
template <int NSTEP = 64, bool LOADS = true> __device__ __forceinline__ void phase_scan_sum(LAS unsigned char* lds, const unsigned* LG, float* SUM, int bid, int G, int wv) {
    const int tid = otid(wv);
    v4u rg[8];
    if (LOADS) { if (bid < NSEG * 16) scan_fetch(rg, LG, bid, tid); } else {
#pragma unroll
        for (int i = 0; i < 8; ++i) rg[i] = (v4u){0u, 0u, 0u, 0u}; }
    for (int item = bid; item < NSEG * 16; item += G) {
        const int seg = item >> 4, cg = item & 15;
        scan_stash(lds, rg, tid);
        __syncthreads();
        if (LOADS && item + G < NSEG * 16) scan_fetch(rg, LG, item + G, tid);
        if (tid < 256) { const int d = wv >> 1, col = tid & 127; const LAS unsigned* T = (const LAS unsigned*)lds + col;
            float h = 0.f, ap = 1.f;
            if (d == 0) scan_col_sum<128, NSTEP>(T, h, ap); else scan_col_sum<-128, NSTEP>(T + 8192 + 63 * 128, h, ap);
            float* o = SUM + ((size_t)(d * NSEG + seg) * D + cg * 128 + col) * 2; o[0] = ap; o[1] = h; }
        __syncthreads();
    }
}
__device__ __forceinline__ void phase_scan_carry(LAS unsigned char* lds, const float* SUM, float* HIN, int bid, int G, int wv) {
    const int tid = otid(wv); typedef float f32x2v __attribute__((ext_vector_type(2)));
    LAS float* MA = (LAS float*)lds; LAS float* MB = MA + 512;
    for (int cb = bid; cb < 32; cb += G) {
        const int ci = cb * 128 + (tid & 127), p = tid >> 7, d = ci >> 11, col = ci & (D - 1);
        f32x2v ab[33];
#pragma unroll
        for (int j = 0; j < 33; ++j) { const int k = p * 33 + j; const int sg = d == 0 ? (k < 4 ? 128 + k : k - 4) : 131 - k; ab[j] = *(const f32x2v*)(SUM + ((size_t)(d * NSEG + sg) * D + col) * 2); }
        float A = 1.f, B = 0.f;
#pragma unroll
        for (int j = 0; j < 33; ++j) { A = ab[j].x * A; B = ab[j].x * B + ab[j].y; }
        MA[p * 128 + (tid & 127)] = A; MB[p * 128 + (tid & 127)] = B;
        __syncthreads();
        float h = 0.f;
#pragma unroll
        for (int q = 0; q < 3; ++q) if (q < p) h = MA[q * 128 + (tid & 127)] * h + MB[q * 128 + (tid & 127)];
#pragma unroll
        for (int j = 0; j < 33; ++j) { const int k = p * 33 + j; const int sg = d == 0 ? (k < 4 ? 128 + k : k - 4) : 131 - k; HIN[(size_t)(d * NSEG + sg) * D + col] = h; h = ab[j].x * h + ab[j].y; }
        __syncthreads();
    }
}
__device__ __forceinline__ void phase_scan_apply(LAS unsigned char* lds, const unsigned* LG, const float* HIN, const bf16* GATE, bf16* Y, int bid, int G, int wv) {
    const int tid = otid(wv);
    v4u rg[8], gtn[2];
    if (bid < NSEG * 16) { scan_fetch(rg, LG, bid, tid);
#pragma unroll
        for (int i = 0; i < 2; ++i) { const int p = tid + i * NTHR, r = p >> 4, c8 = p & 15; gtn[i] = *(const v4u*)(GATE + (size_t)((bid >> 4) * 64 + r) * D + (bid & 15) * 128 + c8 * 8); } }
    const int hd = (wv >> 1) & 1, hcol = tid & 127; float hn = 0.f;
    if (bid < NSEG * 16) hn = HIN[(size_t)(hd * NSEG + (bid >> 4)) * D + (bid & 15) * 128 + hcol];
    for (int item = bid; item < NSEG * 16; item += G) {
        const int seg = item >> 4, cg = item & 15, row0 = seg * 64, col0 = cg * 128;
        scan_stash(lds, rg, tid);
        const v4u gt0 = gtn[0], gt1 = gtn[1]; const float hcur = hn;
        __syncthreads();
        if (item + G < NSEG * 16) { const int nx = item + G; scan_fetch(rg, LG, nx, tid);
#pragma unroll
            for (int i = 0; i < 2; ++i) { const int p = tid + i * NTHR, r = p >> 4, c8 = p & 15; gtn[i] = *(const v4u*)(GATE + (size_t)((nx >> 4) * 64 + r) * D + (nx & 15) * 128 + c8 * 8); }
            hn = HIN[(size_t)(hd * NSEG + (nx >> 4)) * D + (nx & 15) * 128 + hcol]; }
        if (tid < 256) { const int d = wv >> 1, col = tid & 127; LAS unsigned* T = (LAS unsigned*)lds + col;
            const float h = hcur;
            if (d == 0) scan_col_apply<128>(T, h); else scan_col_apply<-128>(T + 8192 + 63 * 128, h); }
        __syncthreads();
#pragma unroll
        for (int i = 0; i < 2; ++i) { const int p = tid + i * NTHR, r = p >> 4, c8 = p & 15;
            const LAS f32x4* hf = (const LAS f32x4*)(lds + (size_t)(r * 128 + c8 * 8) * 4); const LAS f32x4* hb = (const LAS f32x4*)(lds + 32768 + (size_t)(r * 128 + c8 * 8) * 4);
            const f32x4 a0 = hf[0] + hb[0], a1 = hf[1] + hb[1]; const v4u g = i == 0 ? gt0 : gt1;
            v4u o; o.x = pk2(a0[0] * gelu_tanh(bflo(g.x)), a0[1] * gelu_tanh(bfhi(g.x))); o.y = pk2(a0[2] * gelu_tanh(bflo(g.y)), a0[3] * gelu_tanh(bfhi(g.y)));
            o.z = pk2(a1[0] * gelu_tanh(bflo(g.z)), a1[1] * gelu_tanh(bfhi(g.z))); o.w = pk2(a1[2] * gelu_tanh(bflo(g.w)), a1[3] * gelu_tanh(bfhi(g.w)));
            *(v4u*)(Y + (size_t)(row0 + r) * D + col0 + c8 * 8) = o; }
        __syncthreads();
    }
}
template <int MODE> __device__ __forceinline__ void phase_attn(LAS unsigned char* lds, const bf16* Q, const bf16* KB, const bf16* VB, bf16* Z, const float* sink, int bid, int G, int wv) {
    constexpr int KRS = 144, BUFB = 64 * KRS;
    const int tid = otid(wv), lane = tid & 63, wid = wv, r32 = lane & 31, hi = lane >> 5;
    LAS unsigned char* Kl = lds; LAS unsigned char* Vl = lds + 2 * BUFB;
    const int skey = tid >> 3, spiece = tid & 7;
    const int nun = (G == 256) ? 1 : (MODE == 0 ? (264 + G - 1) / G : 0);
    for (int ui = 0; ui < nun; ++ui) {
        int unit = bid + ui * G;
        if (G == 256 && MODE == 1) unit = (bid >= 132 && bid < 140) ? 256 + bid - 132 : 264;
        if (unit >= 264) continue;
        const bool isctx = unit >= 256; const int g = unit & 1; const int qb = isctx ? 128 + ((unit - 256) >> 1) : (unit >> 1);
        const int q0 = qb * 64, head = g * 8 + wid; const unsigned soff = (unsigned)(skey * 128 + g * 64 + spiece * 8);
        int c_lo = 0, nwin = 0;
        if (!isctx) { c_lo = qb < 2 ? 2 - qb : 0; const int c_hi = (130 - qb) < 5 ? (130 - qb) : 5; nwin = c_hi - c_lo; }
        const int nch = nwin + 4;
        bf16x8 qf[2][4];
#pragma unroll
        for (int qt = 0; qt < 2; ++qt)
#pragma unroll
            for (int s = 0; s < 4; ++s) qf[qt][s] = *(const bf16x8*)(Q + (size_t)(q0 + qt * 32 + r32) * 1024 + head * 64 + s * 16 + hi * 8);
        const float sk = sink[head] * LOG2E;
        float mrun[2] = {sk, sk}, lrun[2] = {hi == 0 ? 1.0f : 0.0f, hi == 0 ? 1.0f : 0.0f};
        f32x16 o[2][2];
#pragma unroll
        for (int a = 0; a < 2; ++a)
#pragma unroll
            for (int b = 0; b < 2; ++b)
#pragma unroll
                for (int r = 0; r < 16; ++r) o[a][b][r] = 0.f;
        v4u kvn, vvn;
        {
            const int kr = (0 < nwin) ? q0 - 128 + 64 * c_lo : SEQ;
            const v4u kv = *(const v4u*)(KB + (size_t)__builtin_amdgcn_readfirstlane(kr) * 128 + soff); const v4u vv = *(const v4u*)(VB + (size_t)__builtin_amdgcn_readfirstlane(kr) * 128 + soff);
            const int kr1 = (1 < nwin) ? q0 - 128 + 64 * (c_lo + 1) : SEQ + 64 * (1 - nwin);
            kvn = *(const v4u*)(KB + (size_t)__builtin_amdgcn_readfirstlane(kr1) * 128 + soff); vvn = *(const v4u*)(VB + (size_t)__builtin_amdgcn_readfirstlane(kr1) * 128 + soff);
            *(LAS v4u*)(Kl + skey * KRS + spiece * 16) = kv; *(LAS v4u*)(Vl + skey * KRS + spiece * 16) = vv;
        }
        __syncthreads();
        for (int ci = 0; ci < nch; ++ci) {
            const int buf = ci & 1;
            v4u kv2 = kvn, vv2 = vvn; const bool more = ci + 1 < nch;
            if (ci + 2 < nch) { const int cn = ci + 2; const int kr = (cn < nwin) ? q0 - 128 + 64 * (c_lo + cn) : SEQ + 64 * (cn - nwin);
                kv2 = *(const v4u*)(KB + (size_t)__builtin_amdgcn_readfirstlane(kr) * 128 + soff); vv2 = *(const v4u*)(VB + (size_t)__builtin_amdgcn_readfirstlane(kr) * 128 + soff); }
            const int cw_ = c_lo + ci;
            const bool masked = ci < nwin && (cw_ == 0 || cw_ == 4); const int krow = q0 - 128 + 64 * cw_;
            const LAS unsigned char* Kc = Kl + buf * BUFB; const LAS unsigned char* Vc = Vl + buf * BUFB;
            bf16x8 kf[2][4];
#pragma unroll
            for (int kt = 0; kt < 2; ++kt)
#pragma unroll
                for (int s = 0; s < 4; ++s) kf[kt][s] = *(const LAS bf16x8*)(Kc + (kt * 32 + r32) * KRS + (s * 16 + hi * 8) * 2);
            bf16x8 pf[2][2][2];
#pragma unroll
            for (int qt = 0; qt < 2; ++qt) {
                f32x16 st[2];
#pragma unroll
                for (int kt = 0; kt < 2; ++kt) {
#pragma unroll
                    for (int r = 0; r < 16; ++r) st[kt][r] = -mrun[qt];
#pragma unroll
                    for (int s = 0; s < 4; ++s) st[kt] = __builtin_amdgcn_mfma_f32_32x32x16_bf16(kf[kt][s], qf[qt][s], st[kt], 0, 0, 0); }
                if (masked) {
                    int r32m = r32, him = hi; asm volatile("" : "+v"(r32m), "+v"(him));
                    const int qp = q0 + qt * 32 + r32m;
#pragma unroll
                    for (int kt = 0; kt < 2; ++kt)
#pragma unroll
                        for (int r = 0; r < 16; ++r) { const int dd = krow + kt * 32 + (r & 3) + 8 * (r >> 2) + 4 * him - qp; if (dd > 128 || dd < -128) st[kt][r] = -1e30f; } }
                float mx = max3_(st[0][0], st[1][0], st[0][1]);
#pragma unroll
                for (int r = 1; r < 15; ++r) mx = max3_(mx, st[1][r], st[0][r + 1]);
                { const float ml = st[1][15]; mx = max3_(mx, ml, ml); const float mo = lane_xor(mx, lane, 32); mx = max3_(mx, mo, mo); }
                if (__builtin_amdgcn_ballot_w64(mx > 0.0f) != 0ull) {
                    const float mn = fmaxf(mx, 0.0f), alpha = __builtin_amdgcn_exp2f(-mn); mrun[qt] += mn; lrun[qt] *= alpha;
#pragma unroll
                    for (int dt = 0; dt < 2; ++dt)
#pragma unroll
                        for (int r = 0; r < 16; ++r) o[dt][qt][r] *= alpha;
#pragma unroll
                    for (int kt = 0; kt < 2; ++kt)
#pragma unroll
                        for (int r = 0; r < 16; ++r) st[kt][r] -= mn; }
                float ls4[4] = {0.f, 0.f, 0.f, 0.f};
#pragma unroll
                for (int kt = 0; kt < 2; ++kt) {
#pragma unroll
                    for (int r = 0; r < 16; ++r) { const float p = __builtin_amdgcn_exp2f(st[kt][r]); st[kt][r] = p; ls4[r & 3] += p; }
#pragma unroll
                    for (int s2 = 0; s2 < 2; ++s2) { v4u w; w.x = pg8::cvt_pk_bf16(st[kt][8 * s2 + 0], st[kt][8 * s2 + 1]); w.y = pg8::cvt_pk_bf16(st[kt][8 * s2 + 2], st[kt][8 * s2 + 3]);
                        w.z = pg8::cvt_pk_bf16(st[kt][8 * s2 + 4], st[kt][8 * s2 + 5]); w.w = pg8::cvt_pk_bf16(st[kt][8 * s2 + 6], st[kt][8 * s2 + 7]); pf[qt][kt][s2] = __builtin_bit_cast(bf16x8, w); } }
                lrun[qt] += (ls4[0] + ls4[1]) + (ls4[2] + ls4[3]);
            }
            {
                const int i16 = lane & 15, qq = i16 >> 2, pp = i16 & 3;
                const LAS unsigned char* vb = Vc + (4 * hi + qq) * KRS + (16 * ((lane >> 4) & 1) + 4 * pp) * 2;
#pragma unroll
                for (int kt = 0; kt < 2; ++kt) {
                    s16x4 vlo[2][2], vhi[2][2];
#pragma unroll
                    for (int dt = 0; dt < 2; ++dt)
#pragma unroll
                        for (int s2 = 0; s2 < 2; ++s2) { const LAS unsigned char* va = vb + (kt * 32 + 16 * s2) * KRS + dt * 64;
                            vlo[dt][s2] = __builtin_bit_cast(s16x4, __builtin_amdgcn_ds_read_tr16_b64_v4i16((LAS s16x4*)va));
                            vhi[dt][s2] = __builtin_bit_cast(s16x4, __builtin_amdgcn_ds_read_tr16_b64_v4i16((LAS s16x4*)(va + 8 * KRS))); }
#pragma unroll
                    for (int s2 = 0; s2 < 2; ++s2)
#pragma unroll
                        for (int dt = 0; dt < 2; ++dt) { const s16x4 lo = vlo[dt][s2], hi4 = vhi[dt][s2];
                            const bf16x8 vf = (bf16x8){lo[0], lo[1], lo[2], lo[3], hi4[0], hi4[1], hi4[2], hi4[3]};
#pragma unroll
                            for (int qt = 0; qt < 2; ++qt) o[dt][qt] = __builtin_amdgcn_mfma_f32_32x32x16_bf16(vf, pf[qt][kt][s2], o[dt][qt], 0, 0, 0); }
                }
            }
            if (more) { const int nb = buf ^ 1; *(LAS v4u*)(Kl + nb * BUFB + skey * KRS + spiece * 16) = kvn; *(LAS v4u*)(Vl + nb * BUFB + skey * KRS + spiece * 16) = vvn; }
            kvn = kv2; vvn = vv2;
            __syncthreads();
        }
        int r32z = r32, hiz = hi; asm volatile("" : "+v"(r32z), "+v"(hiz));
#pragma unroll
        for (int qt = 0; qt < 2; ++qt) {
            float l = lrun[qt]; l += lane_xor(l, lane, 32);
            const float inv = frcp(l);
            bf16* zr = Z + (size_t)(q0 + qt * 32 + r32z) * D + 1024 + head * 64;
#pragma unroll
            for (int dt = 0; dt < 2; ++dt)
#pragma unroll
                for (int r4 = 0; r4 < 4; ++r4) { v2u w; w.x = pk2(o[dt][qt][4 * r4 + 0] * inv, o[dt][qt][4 * r4 + 1] * inv); w.y = pk2(o[dt][qt][4 * r4 + 2] * inv, o[dt][qt][4 * r4 + 3] * inv);
                    *(v2u*)(zr + dt * 32 + 8 * r4 + 4 * hiz) = w; }
        }
    }
}

constexpr int PH_FINAL = 2 + 16 * DEPTH, PH_END = PH_FINAL + 1;
__global__ void __launch_bounds__(NTHR, 2) fwd_kernel(Args a) {
    extern __shared__ __attribute__((aligned(16))) unsigned char lds_raw[];
    LAS unsigned char* lds = (LAS unsigned char*)lds_raw;
    volatile LAS unsigned* MISC = (volatile LAS unsigned*)(lds + MISC_OFF);
    const int tid = threadIdx.x; const int wv = __builtin_amdgcn_readfirstlane(tid >> 6);
    for (int u = tid; u < (LDS_BYTES - RING_BYTES) / 4; u += NTHR) ((LAS unsigned*)(lds + RING_BYTES))[u] = 0u;
    __syncthreads();
    if (tid < 25) ((LAS unsigned long long*)(lds + PTAB_OFF))[tid] = (unsigned long long)a.in[tid];
    __syncthreads();
    const int lo = a.ph_lo, hi = a.ph_hi;
    XcdBarrier bar; bar.bar = (unsigned*)(a.ws + WS_CTL) + CW_BAR; bar.x = 0; bar.st = nullptr;
    if (hi - lo > 1) bar = xcd_barrier_post((unsigned*)(a.ws + WS_CTL) + CW_BAR, MISC + 8);
#define IN(k) in_range(lo, hi, (k))
#define SEAM(k) do { if (IN(k) && IN((k) + 1)) xcd_barrier(bar, wv); } while (0)
#define BG(frac_num) do { } while (0)
#define WSP unsigned char* ws = opaque(a.ws); const int bid = obid(), G = ogrid(); (void)bid; (void)G

    if (IN(0)) { WSP; phase_prologue(ws, lds, bid, G, wv); __syncthreads(); if (PROBE == 4) { phase_prologue(ws, lds, bid, G, wv); __syncthreads(); } } SEAM(0);
    if (IN(1)) { WSP; mod_final(ws, 0, bid, G, wv); } SEAM(1);

#pragma unroll 1
    for (int L = 0; L < DEPTH; ++L) {
        const int pb = 2 + 16 * L, li = L >> 1;
#define MODL ((const float*)(ws + WS_MOD) + (size_t)(L * 2 + 0) * NMOD6)
#define MODC ((const float*)(ws + WS_MOD) + (size_t)(L * 2 + 1) * NMOD6)
        const bool ctx_out = L < DEPTH - 1;
        if (PROBE == 20 && hi - lo > 1) { for (int rep = 0; rep < 8; ++rep) xcd_barrier(bar, wv); }
        if (IN(pb + 0)) { WSP;
            phase_norm(L == 0 ? inp(lds, I_X) : (const float*)nullptr, L == 0 ? inp(lds, I_CTX) : (const float*)nullptr, (bf16*)(ws + WS_X), (bf16*)(ws + WS_H), inp(lds, I_GMIX) + L * D, MODL, MODC, 0, 1, lds, MT, (const float*)(ws + WS_PART), L > 0 ? 4 : 0, (const float*)(ws + WS_MOD) + (size_t)((L > 0 ? L - 1 : 0) * 2 + 1) * NMOD6 + 5 * D, bid, G, wv); }
        SEAM(pb + 0);
        if ((L & 1) == 0) {
            if (IN(pb + 1)) { WSP;
                pg8::Gemm g = pg8::mk_gemm((const bf16*)(ws + WS_H), (const bf16*)(ws + WS_WINFA) + (size_t)li * FA_IN * D, D, D, D, 0, 0); pg8::Order S; S.init(33, 9, 1, G, bid, g.K);
                EpiRope E{(bf16*)(ws + WS_F), (bf16*)(ws + WS_Q), (bf16*)(ws + WS_KB), (bf16*)(ws + WS_VB), (const float*)(ws + WS_ROPE), (const float*)(ws + WS_ROPE) + 128 * 16};
                pg8::gemm_phase<EpiRope, true>(lds, g, S, E, wv);
                if (PROBE == 6) { __syncthreads(); pg8::gemm_phase<EpiRope, true>(lds, g, S, E, wv); }
                { const int fi = tail_first(297, G); bg_slot(ws, lds, L + 1, bid - fi, G - fi, true, 0, 30, wv); }
            }
            SEAM(pb + 1);
            if (IN(pb + 2)) {
                {   WSP;
                    pg8::Gemm g = pg8::mk_gemm((const bf16*)(ws + WS_DFTC), (const bf16*)(ws + WS_F), 256, 1024, 256, 0, 256); g.rmB = 64; g.hsB = 1024 * 2; g.tsB = 2 * 1024 * 2;
                    pg8::Order S; S.init(2, 32, 4, G, bid, g.K);
                    EpiX3 E{(bf16*)(ws + WS_VT)};
                    pg8::gemm_phase<EpiX3, true>(lds, g, S, E, wv);
                    if (PROBE == 12) { __syncthreads(); pg8::gemm_phase<EpiX3, true>(lds, g, S, E, wv); }
                }
                {   WSP;
                    pg8::Gemm g = pg8::mk_gemm((const bf16*)(ws + WS_DFTC), (const bf16*)(ws + WS_F) + (size_t)SEQ * 1024, 256, 1024, 256, 0, 256); pg8::Order S; S.init(2, 1, 4, G, (bid + G - 16) % G, g.K);
                    EpiStore E{(bf16*)(ws + WS_VTC), 256, (long)512 * 256, 0, 0, 1.0f};
                    pg8::gemm_phase<EpiStore, true>(lds, g, S, E, wv);
                }
                __syncthreads();
                {   WSP;
                    phase_attn<0>(lds, (const bf16*)(ws + WS_Q), (const bf16*)(ws + WS_KB), (const bf16*)(ws + WS_VB), (bf16*)(ws + WS_Z), inp(lds, I_SINK) + li * 16, bid, G, wv);
                    __syncthreads();
                    { const int idx = G == 256 ? (bid < 16 ? bid : (bid >= 24 ? bid - 8 : -1)) : bid, nidle = G == 256 ? 248 : G;
                      (void)idx; (void)nidle; }
                }
            }
            SEAM(pb + 2);
            if (IN(pb + 3)) {
                {   WSP;
                    pg8::Gemm g = pg8::mk_gemm((const bf16*)(ws + WS_DA), (const bf16*)(ws + WS_VT), 256, 256, 256, 0, 0); pg8::Order S; S.init(1, 256, 1, G, bid, g.K);
                    EpiTw E{(bf16*)(ws + WS_ZP), (const float*)(ws + WS_TW), (const float*)(ws + WS_TW) + 128 * 64};
                    pg8::gemm_phase<EpiTw, true>(lds, g, S, E, wv);
                    if (PROBE == 10) { __syncthreads(); pg8::gemm_phase<EpiTw, true>(lds, g, S, E, wv); }
                }
            }
            SEAM(pb + 3);
            if (IN(pb + 4)) { WSP;
                pg8::Gemm g = pg8::mk_gemm((const bf16*)(ws + WS_DB4), (const bf16*)(ws + WS_ZP), 512, 16384, 512, 0, 512); pg8::Order S; S.init(1, 4, 32, G, bid, g.K);
                EpiFftOut E{(bf16*)(ws + WS_Z), 1.0f / 1448.1546878700494f};
                pg8::gemm_phase<EpiFftOut, true>(lds, g, S, E, wv);
                {
                    pg8::Gemm g2 = pg8::mk_gemm((const bf16*)(ws + WS_DFTNC), (const bf16*)(ws + WS_VTC), 512, 512, 512, 0, 0); pg8::Order S2; S2.init(1, 4, 1, G, G >= 256 ? (bid + G - 128) % G : bid, g2.K);
                    EpiStore E2{(bf16*)(ws + WS_Z) + (size_t)SEQ * D, D, 0, 0, 0, 1.0f / 256.0f};
                    pg8::gemm_phase<EpiStore, true>(lds, g2, S2, E2, wv);
                }
                __syncthreads();
                phase_attn<1>(lds, (const bf16*)(ws + WS_Q), (const bf16*)(ws + WS_KB), (const bf16*)(ws + WS_VB), (bf16*)(ws + WS_Z), inp(lds, I_SINK) + li * 16, bid, G, wv);
                __syncthreads();
                { const int fi = tail_first(128, G); bg_slot(ws, lds, L == 0 ? 0 : 3, bid - fi, G - fi, false, 30, L == 0 ? 66 : 53, wv); }
            }
            SEAM(pb + 4);
            if (IN(pb + 5)) { WSP;
                pg8::Gemm g = pg8::mk_gemm((const bf16*)(ws + WS_Z), (const bf16*)(ws + WS_WOUTFA) + (size_t)li * D * D, D, D, D, 0, 0); pg8::OrderSplit S; S.init(32, 8, 1, G, bid, g.K); S.extra(4, 32, 8, 512);
                EpiResid E{(bf16*)(ws + WS_X), MODL + 2 * D, MODC + 2 * D, (float*)(ws + WS_PART), L == 0 ? inp(lds, I_X) : (const float*)nullptr, (const bf16*)(ws + WS_X)};
                pg8::gemm_phase<EpiResid, true>(lds, g, S, E, wv);
                { const int fi = tail_first(256 + 32, G); bg_slot(ws, lds, L == 0 ? 0 : 3, bid - fi, G - fi, false, L == 0 ? 66 : 53, L == 0 ? 78 : 61, wv); }
            }
            SEAM(pb + 5);
        } else {
            if (IN(pb + 1)) { WSP;
                pg8::Gemm g = pg8::mk_gemm((const bf16*)(ws + WS_H), (const bf16*)(ws + WS_WINRG) + (size_t)li * 4096 * D, D, D, D, 0, 0); pg8::OrderSplit S; S.init(32, 16, 1, G, bid, g.K); S.extra(2, 32, 16, 1024);
                EpiRgIn E{(bf16*)(ws + WS_GATE), (bf16*)(ws + WS_XS), (float*)(ws + WS_PART2)};
                pg8::gemm_phase<EpiRgIn, true>(lds, g, S, E, wv);
                if (PROBE == 15) { __syncthreads(); pg8::gemm_phase<EpiRgIn, true>(lds, g, S, E, wv); }
                if (L == 1) { const int fi = tail_first(512 + 32, G); bg_slot(ws, lds, 2, bid - fi, G - fi, true, 0, 5, wv); }
            }
            SEAM(pb + 1);
            if (IN(pb + 2)) { WSP; phase_conv4((const bf16*)(ws + WS_XS), (bf16*)(ws + WS_XSC), (bf16*)(ws + WS_GATE), (const float*)(ws + WS_PART2), inp(lds, I_RGCW) + (size_t)li * 4 * D, inp(lds, I_RGCB) + (size_t)li * D, bid, G, wv); }
            SEAM(pb + 2);
            if (IN(pb + 3)) { WSP;
                pg8::Gemm g = pg8::mk_gemm((const bf16*)(ws + WS_XSC), (const bf16*)(ws + WS_WGATE) + (size_t)li * 8 * 1024 * 256, D, 256, 256, 256, (long)1024 * 256); pg8::Order S; S.init(33, 4, 8, G, bid, g.K);
                EpiGates E{inp(lds, I_RGBA) + (size_t)li * 2 * D, inp(lds, I_RGBI) + (size_t)li * 2 * D, (const float*)(ws + WS_SP8) + (size_t)li * 2 * D, (const bf16*)(ws + WS_XSC), (unsigned*)(ws + WS_LG)};
                pg8::gemm_phase<EpiGates, true>(lds, g, S, E, wv);
                if (PROBE == 7) { __syncthreads(); pg8::gemm_phase<EpiGates, true>(lds, g, S, E, wv); }
                if (L == 1) { const int fi = tail_first(33 * 4 * 8, G); bg_slot(ws, lds, 2, bid - fi, G - fi, false, 5, 25, wv); }
            }
            SEAM(pb + 3);
            if (IN(pb + 4)) { WSP; phase_scan_sum(lds, (const unsigned*)(ws + WS_LG), (float*)(ws + WS_SCAN), bid, G, wv); if (PROBE == 8) phase_scan_sum(lds, (const unsigned*)(ws + WS_LG), (float*)(ws + WS_SCAN), bid, G, wv);
                if (PROBE == 13) phase_scan_sum<1, true>(lds, (const unsigned*)(ws + WS_LG), (float*)(ws + WS_HF), bid, G, wv);
                if (PROBE == 14) phase_scan_sum<64, false>(lds, (const unsigned*)(ws + WS_LG), (float*)(ws + WS_HF), bid, G, wv); }
            SEAM(pb + 4);
            if (IN(pb + 5)) { WSP; phase_scan_carry(lds, (const float*)(ws + WS_SCAN), (float*)(ws + WS_SCAN + 5 * MiB), bid, G, wv); }
            SEAM(pb + 5);
            if (IN(pb + 6)) { WSP; phase_scan_apply(lds, (const unsigned*)(ws + WS_LG), (const float*)(ws + WS_SCAN + 5 * MiB), (const bf16*)(ws + WS_GATE), (bf16*)(ws + WS_Z), bid, G, wv); if (PROBE == 9) phase_scan_apply(lds, (const unsigned*)(ws + WS_LG), (const float*)(ws + WS_SCAN + 5 * MiB), (const bf16*)(ws + WS_GATE), (bf16*)(ws + WS_Z), bid, G, wv); }
            SEAM(pb + 6);
            if (IN(pb + 7)) { WSP;
                pg8::Gemm g = pg8::mk_gemm((const bf16*)(ws + WS_Z), (const bf16*)(ws + WS_WOUTRG) + (size_t)li * D * D, D, D, D, 0, 0); pg8::OrderSplit S; S.init(32, 8, 1, G, bid, g.K); if (ctx_out) S.extra(4, 32, 8, 512);
                EpiResid E{(bf16*)(ws + WS_X), MODL + 2 * D, MODC + 2 * D, (float*)(ws + WS_PART), (const float*)nullptr, (const bf16*)(ws + WS_X)};
                pg8::gemm_phase<EpiResid, true>(lds, g, S, E, wv);
                if (L == 1) { const int fi = tail_first(256 + 32, G); bg_slot(ws, lds, 2, bid - fi, G - fi, false, 25, 37, wv); }
            }
            SEAM(pb + 7);
        }
        if (IN(pb + 8)) { WSP;
            phase_norm((const float*)nullptr, L == 0 ? inp(lds, I_CTX) : (const float*)nullptr, (bf16*)(ws + WS_X), (bf16*)(ws + WS_H), inp(lds, I_GFFN) + L * D, MODL, MODC, 3, 4, lds, ctx_out ? MT : SEQ, (const float*)(ws + WS_PART), 4, MODC + 2 * D, bid, G, wv);
            if (PROBE == 3) phase_norm((const float*)nullptr, (const float*)nullptr, (bf16*)(ws + WS_X), (bf16*)(ws + WS_H), inp(lds, I_GFFN) + L * D, MODL, MODC, 3, 4, lds, ctx_out ? MT : SEQ, (const float*)(ws + WS_PART), 0, MODC + 2 * D, bid, G, wv); }
        SEAM(pb + 8);
        if (IN(pb + 9)) { WSP;
            pg8::Gemm g = pg8::mk_gemm((const bf16*)(ws + WS_H) - D, (const bf16*)(ws + WS_WUP) + (size_t)L * DFF2 * D, D, D, D, (long)(SEQ + 1) * D, 0); g.tsA = (long)254 * D * 2;
            pg8::OrderSplit S; S.init(33, 44, 1, G, bid, g.K); if (ctx_out) S.extra(1, 0, 44, D, 1);
            EpiConvAct E{(bf16*)(ws + WS_ACT), inp(lds, I_FCW) + (size_t)L * 3 * DFF2, inp(lds, I_FCB) + (size_t)L * DFF2, (LAS float*)(lds + EX_OFF), (LAS float*)(lds + WB_OFF)};
            pg8::gemm_phase<EpiConvAct, true>(lds, g, S, E, wv);
            if (PROBE == 1) { __syncthreads(); pg8::gemm_phase<EpiConvAct, true>(lds, g, S, E, wv); }
            if (ctx_out) { const int fi = tail_first(33 * 44 + 44, G); bg_slot(ws, lds, L == 0 ? 0 : L + 1, bid - fi, G - fi, false, L == 0 ? 78 : (L == 1 ? 37 : 61), L == 0 ? 100 : (L == 1 ? 55 : 76), wv); }
            {
                const int fi = tail_first(33 * 44 + (ctx_out ? 44 : 0), G);
                if (G - fi >= 8) { if (bid >= fi) mod_final(ws, L + 1, bid - fi, G - fi, wv); } else mod_final(ws, L + 1, bid, G, wv); }
        }
        SEAM(pb + 9);
        if (IN(pb + 11)) { WSP;
            pg8::Gemm g = pg8::mk_gemm((const bf16*)(ws + WS_ACT), (const bf16*)(ws + WS_WDOWN) + (size_t)L * D * DFF, DFF, DFF, DFF, 0, 0); pg8::OrderSplit S; S.init(32, 8, 1, G, bid, g.K); if (ctx_out) S.extra(4, 32, 8, 1408);
            EpiResid E{(bf16*)(ws + WS_X), MODL + 5 * D, MODC + 5 * D, (float*)(ws + WS_PART), (const float*)nullptr, (const bf16*)(ws + WS_X)};
            pg8::gemm_phase<EpiResid, true>(lds, g, S, E, wv);
            if (ctx_out) { const int fi = tail_first(256 + 32, G); bg_slot(ws, lds, L + 1, bid - fi, G - fi, false, L == 0 ? 30 : (L == 1 ? 55 : 76), 100, wv); }
            if (PROBE == 16) { __syncthreads(); EpiResid E0{(bf16*)(ws + WS_X), (const float*)(ws + 524288), (const float*)(ws + 524288), (float*)(ws + WS_PART), (const float*)nullptr, (const bf16*)(ws + WS_X)}; pg8::gemm_phase<EpiResid, true>(lds, g, S, E0, wv); }
        }
        SEAM(pb + 11);
    }
    if (IN(PH_FINAL)) { WSP; phase_final((const bf16*)(ws + WS_X), a.out, inp(lds, I_GFINAL), bid, G, wv); }
#undef IN
#undef SEAM
#undef WSP
#undef MODL
#undef MODC
}

extern "C" void kernel_launch(void* const* d_in, const int* in_sizes, int n_in, void* d_out, int out_size, void* d_ws, size_t ws_size, hipStream_t stream) {
    static int grid = 0;
    if (grid == 0) {
        if (n_in != 25 || out_size != SEQ * D || ws_size < WS_END) { fprintf(stderr, "kernel_launch: unexpected shapes (n_in %d out %d ws %zu)\n", n_in, out_size, ws_size); grid = -1; return; }
        int dev = 0, cus = 0, per_cu = 0;
        if (hipGetDevice(&dev) != hipSuccess || hipDeviceGetAttribute(&cus, hipDeviceAttributeMultiprocessorCount, dev) != hipSuccess) { grid = -1; return; }
        if (hipFuncSetAttribute((const void*)fwd_kernel, hipFuncAttributeMaxDynamicSharedMemorySize, LDS_BYTES) != hipSuccess) { fprintf(stderr, "kernel_launch: hipFuncSetAttribute failed\n"); grid = -1; return; }
        if (hipOccupancyMaxActiveBlocksPerMultiprocessor(&per_cu, (const void*)fwd_kernel, NTHR, LDS_BYTES) != hipSuccess || per_cu < 1) fprintf(stderr, "kernel_launch: occupancy query says %d\n", per_cu);
        (void)hipGetLastError();
        grid = cus;
    }
    if (grid < 0) return;
    (void)hipMemsetAsync((char*)d_ws + WS_CTL, 0, CTL_ZERO_BYTES, stream);
    Args a{};
    for (int i = 0; i < 25; ++i) a.in[i] = (const float*)d_in[i];
    a.out = (float*)d_out; a.ws = (unsigned char*)d_ws;
#if MK_ONE_LAUNCH
    a.ph_lo = 0; a.ph_hi = PH_END;
    hipLaunchKernelGGL(fwd_kernel, dim3(grid), dim3(NTHR), LDS_BYTES, stream, a);
#else
    for (int p = 0; p < PH_END; ++p) {
        if (p >= 2 && p < PH_FINAL) { const int L = (p - 2) >> 4, k = (p - 2) & 15; const bool fa = (L & 1) == 0;
            const bool used = fa ? (k <= 5 || (k >= 8 && k <= 11)) : (k <= 7 || (k >= 8 && k <= 11)); if (!used) continue; }
        a.ph_lo = p; a.ph_hi = p + 1;
        hipLaunchKernelGGL(fwd_kernel, dim3(grid), dim3(NTHR), LDS_BYTES, stream, a);
    }
#endif
}
```
